# Optimizing an MI355X kernel written in HIP

```python
import jax, jax.numpy as jnp
from jax import lax
import numpy as np

D_MODEL = 2048
BATCH = 32
SEQ = 256
DEPTH = 4
DEC_BATCH = 2
DEC_SEQ = 2048
PAST_LEN = 512

GRID_W = 64
HEAD_DIM = 64
ATTN_W = D_MODEL // 2
N_HEADS = ATTN_W // HEAD_DIM
N_KV_HEADS = 4
GQA_GROUP = N_HEADS // N_KV_HEADS
KV_W = N_KV_HEADS * HEAD_DIM
POOL_W = D_MODEL // 4
POOL_WINDOWS = (2, 4, 8, 16)
POOL_GROUPS = len(POOL_WINDOWS)
POOL_GW = POOL_W // POOL_GROUPS
CONV_W = D_MODEL // 4
CONV_K = 31
MIX_W = ATTN_W + POOL_W + CONV_W
IN_W = ATTN_W + 2 * KV_W + POOL_W + 2 * CONV_W
WINDOW = 128
BLOCK = 128
D_FF = 4 * D_MODEL
ROPE_BASE = 10000.0
EPS = 1e-6
NEG = -1e30

kernel_name = 'hybrid_pool_swa_conformer_flow_step'


def rms_norm(x, g):
    xf = x.astype(jnp.float32)
    y = xf * lax.rsqrt(jnp.mean(xf * xf, axis=-1, keepdims=True) + EPS)
    return (y * g.astype(jnp.float32)).astype(x.dtype)


def layer_norm(x, g, b):
    xf = x.astype(jnp.float32)
    mu = jnp.mean(xf, axis=-1, keepdims=True)
    var = jnp.mean(jnp.square(xf - mu), axis=-1, keepdims=True)
    y = (xf - mu) * lax.rsqrt(var + EPS)
    return (y * g.astype(jnp.float32) + b.astype(jnp.float32)).astype(x.dtype)


def rope_2d(x, rows):
    half = HEAD_DIM // 2
    quarter = half // 2
    inv_freq = 1.0 / (ROPE_BASE ** (jnp.arange(quarter, dtype=jnp.float32) / quarter))
    row_pos = jnp.repeat(jnp.arange(rows, dtype=jnp.float32), GRID_W)
    col_pos = jnp.tile(jnp.arange(GRID_W, dtype=jnp.float32), rows)

    def rotate(u, pos):
        ang = pos[:, None] * inv_freq[None, :]
        cos = jnp.cos(ang)[None, :, None, :]
        sin = jnp.sin(ang)[None, :, None, :]
        u1, u2 = u[..., :quarter], u[..., quarter:]
        return jnp.concatenate([u1 * cos - u2 * sin, u2 * cos + u1 * sin], axis=-1)

    xf = x.astype(jnp.float32)
    out = jnp.concatenate([rotate(xf[..., :half], row_pos), rotate(xf[..., half:], col_pos)], axis=-1)
    return out.astype(x.dtype)


def sink_softmax(s, sink_b):
    sk = jnp.broadcast_to(sink_b.astype(jnp.float32), s.shape[:-1] + (1,))
    return jax.nn.softmax(jnp.concatenate([s, sk], axis=-1), axis=-1)[..., :-1]


def ctx_attention(q, k, v, sink):
    B, S = q.shape[0], q.shape[1]
    qg = q.reshape(B, S, N_KV_HEADS, GQA_GROUP, HEAD_DIM)
    s = jnp.einsum('bqkgd,bpkd->bkgqp', qg, k).astype(jnp.float32) * (HEAD_DIM ** -0.5)
    p = sink_softmax(s, sink.reshape(1, N_KV_HEADS, GQA_GROUP, 1, 1))
    o = jnp.einsum('bkgqp,bpkd->bqkgd', p.astype(v.dtype), v)
    return o.reshape(B, S, ATTN_W)


def latent_attention(q, k, v, ck, cv, sink):
    B, T = q.shape[0], q.shape[1]
    nb = T // BLOCK
    qb = q.reshape(B, nb, BLOCK, N_KV_HEADS, GQA_GROUP, HEAD_DIM)
    pad = ((0, 0), (BLOCK, BLOCK), (0, 0), (0, 0))
    kp = jnp.pad(k, pad).reshape(B, nb + 2, BLOCK, N_KV_HEADS, HEAD_DIM)
    vp = jnp.pad(v, pad).reshape(B, nb + 2, BLOCK, N_KV_HEADS, HEAD_DIM)
    kw = jnp.concatenate([kp[:, :-2], kp[:, 1:-1], kp[:, 2:]], axis=2)
    vw = jnp.concatenate([vp[:, :-2], vp[:, 1:-1], vp[:, 2:]], axis=2)
    qi = jnp.arange(BLOCK)
    kj = jnp.arange(3 * BLOCK)
    bi = jnp.arange(nb)
    rel = kj[None, :] - BLOCK - qi[:, None]
    kpos = bi[:, None] * BLOCK - BLOCK + kj[None, :]
    valid = (jnp.abs(rel) <= WINDOW)[None] & ((kpos >= 0) & (kpos < T))[:, None, :]
    scale = HEAD_DIM ** -0.5
    s_loc = jnp.einsum('bnqkgd,bnskd->bnkgqs', qb, kw).astype(jnp.float32) * scale
    s_loc = jnp.where(valid[None, :, None, None], s_loc, NEG)
    s_ctx = jnp.einsum('bnqkgd,bpkd->bnkgqp', qb, ck).astype(jnp.float32) * scale
    n_loc = 3 * BLOCK
    p = sink_softmax(jnp.concatenate([s_loc, s_ctx], axis=-1),
                     sink.reshape(1, 1, N_KV_HEADS, GQA_GROUP, 1, 1)).astype(v.dtype)
    o = (jnp.einsum('bnkgqs,bnskd->bnqkgd', p[..., :n_loc], vw)
         + jnp.einsum('bnkgqp,bpkd->bnqkgd', p[..., n_loc:], cv))
    return o.reshape(B, T, ATTN_W)


def pool_mixer(u, w_pool, pool_scale):
    B, S = u.shape[0], u.shape[1]
    uf = u.astype(jnp.float32).reshape(B, S, POOL_GROUPS, POOL_GW)
    cs = jnp.concatenate([jnp.zeros((B, 1, POOL_GROUPS, POOL_GW), jnp.float32),
                          lax.cumsum(uf, axis=1)], axis=1)
    t = jnp.arange(S)
    halfw = jnp.array([w // 2 for w in POOL_WINDOWS])
    wins = jnp.array(POOL_WINDOWS)
    lo = jnp.clip(t[:, None] - halfw[None, :], 0, S)
    hi = jnp.clip(t[:, None] - halfw[None, :] + wins[None, :], 0, S)
    gidx = jnp.arange(POOL_GROUPS)[None, :]
    wsum = cs[:, hi, gidx] - cs[:, lo, gidx]
    mean = wsum / (hi - lo).astype(jnp.float32)[None, :, :, None]
    pooled = (mean - uf).astype(u.dtype)
    y = jnp.einsum('bsgc,gcd->bsgd', pooled, w_pool).reshape(B, S, POOL_W)
    return y * pool_scale


def conv_mixer(u, conv_dw, conv_b, ln_g, ln_b, w_pw):
    a, g = jnp.split(u, 2, axis=-1)
    h = a * jax.nn.sigmoid(g)
    h = lax.conv_general_dilated(h, conv_dw[:, None, :], window_strides=(1,),
                                 padding=[(CONV_K // 2, CONV_K // 2)],
                                 dimension_numbers=('NWC', 'WIO', 'NWC'),
                                 feature_group_count=CONV_W) + conv_b
    h = jax.nn.silu(layer_norm(h, ln_g, ln_b))
    return h @ w_pw


def trunk_layer(x, cvec, ctx_kv, lp):
    mods = jnp.split(jax.nn.silu(cvec) @ lp['w_ada'] + lp['b_ada'], 6, axis=-1)
    sh1, sc1, g1, sh2, sc2, g2 = [m[:, None, :] for m in mods]
    B, S = x.shape[0], x.shape[1]
    h = rms_norm(x, lp['g_pre1']) * (1.0 + sc1) + sh1
    z = h @ lp['w_in']
    o1 = ATTN_W
    o2 = o1 + KV_W
    o3 = o2 + KV_W
    o4 = o3 + POOL_W
    q = z[..., :o1].reshape(B, S, N_HEADS, HEAD_DIM)
    k = z[..., o1:o2].reshape(B, S, N_KV_HEADS, HEAD_DIM)
    v = z[..., o2:o3].reshape(B, S, N_KV_HEADS, HEAD_DIM)
    pu = z[..., o3:o4]
    cu = z[..., o4:]
    if ctx_kv is None:
        attn = ctx_attention(q, k, v, lp['sink'])
        kv_out = (k, v)
    else:
        rows = S // GRID_W
        attn = latent_attention(rope_2d(q, rows), rope_2d(k, rows), v, ctx_kv[0], ctx_kv[1], lp['sink'])
        kv_out = None
    pool = pool_mixer(pu, lp['w_pool'], lp['pool_scale'])
    conv = conv_mixer(cu, lp['conv_dw'], lp['conv_b'], lp['conv_ln_g'], lp['conv_ln_b'], lp['w_conv_pw'])
    mix = jnp.concatenate([attn, pool, conv], axis=-1) @ lp['w_out']
    x = x + g1 * rms_norm(mix, lp['g_post1'])
    h = rms_norm(x, lp['g_pre2']) * (1.0 + sc2) + sh2
    f = jnp.square(jax.nn.relu(h @ lp['w_mlp1'])) @ lp['w_mlp2']
    x = x + g2 * rms_norm(f, lp['g_post2'])
    return x, kv_out


def setup_inputs(seed: int = 0) -> dict:
    key = jax.random.key(seed)
    ks = jax.random.split(key, 24)

    def nrm(k, shape, scale):
        return jax.random.normal(k, shape, jnp.float32) * scale

    return {
        'x_prompt': nrm(ks[0], (BATCH, SEQ, D_MODEL), 1.0),
        'x_sample': nrm(ks[1], (DEC_BATCH, DEC_SEQ, D_MODEL), 1.0),
        'cache_k': nrm(ks[2], (DEC_BATCH, DEPTH, PAST_LEN, N_KV_HEADS, HEAD_DIM), 1.0),
        'cache_v': nrm(ks[3], (DEC_BATCH, DEPTH, PAST_LEN, N_KV_HEADS, HEAD_DIM), 1.0),
        'c': nrm(ks[4], (DEC_BATCH, D_MODEL), 1.0),
        'c_ctx': nrm(ks[5], (D_MODEL,), 1.0),
        'w_ada': nrm(ks[6], (DEPTH, D_MODEL, 6 * D_MODEL), D_MODEL ** -0.5),
        'b_ada': nrm(ks[7], (DEPTH, 6 * D_MODEL), 0.02),
        'g_pre1': 1.0 + nrm(ks[8], (DEPTH, D_MODEL), 0.02),
        'g_post1': 1.0 + nrm(ks[9], (DEPTH, D_MODEL), 0.02),
        'g_pre2': 1.0 + nrm(ks[10], (DEPTH, D_MODEL), 0.02),
        'g_post2': 1.0 + nrm(ks[11], (DEPTH, D_MODEL), 0.02),
        'w_in': nrm(ks[12], (DEPTH, D_MODEL, IN_W), D_MODEL ** -0.5),
        'sink': nrm(ks[13], (DEPTH, N_HEADS), 0.5),
        'w_pool': nrm(ks[14], (DEPTH, POOL_GROUPS, POOL_GW, POOL_GW), POOL_GW ** -0.5),
        'pool_scale': 1.0 + nrm(ks[15], (DEPTH, POOL_W), 0.1),
        'conv_dw': nrm(ks[16], (DEPTH, CONV_K, CONV_W), CONV_K ** -0.5),
        'conv_b': nrm(ks[17], (DEPTH, CONV_W), 0.02),
        'conv_ln_g': 1.0 + nrm(ks[18], (DEPTH, CONV_W), 0.02),
        'conv_ln_b': nrm(ks[19], (DEPTH, CONV_W), 0.02),
        'w_conv_pw': nrm(ks[20], (DEPTH, CONV_W, CONV_W), CONV_W ** -0.5),
        'w_out': nrm(ks[21], (DEPTH, MIX_W, D_MODEL), MIX_W ** -0.5),
        'w_mlp1': nrm(ks[22], (DEPTH, D_MODEL, D_FF), D_MODEL ** -0.5),
        'w_mlp2': nrm(ks[23], (DEPTH, D_FF, D_MODEL), D_FF ** -0.5),
    }


def reference(x_prompt, x_sample, cache_k, cache_v, c, c_ctx, w_ada, b_ada, g_pre1, g_post1,
              g_pre2, g_post2, w_in, sink, w_pool, pool_scale, conv_dw, conv_b, conv_ln_g,
              conv_ln_b, w_conv_pw, w_out, w_mlp1, w_mlp2):
    xp = x_prompt
    xs = x_sample
    cvec_ctx = c_ctx[None, :]
    new_ks = []
    new_vs = []
    for l in range(DEPTH):
        lp = {
            'w_ada': w_ada[l], 'b_ada': b_ada[l],
            'g_pre1': g_pre1[l], 'g_post1': g_post1[l], 'g_pre2': g_pre2[l], 'g_post2': g_post2[l],
            'w_in': w_in[l], 'sink': sink[l], 'w_pool': w_pool[l], 'pool_scale': pool_scale[l],
            'conv_dw': conv_dw[l], 'conv_b': conv_b[l], 'conv_ln_g': conv_ln_g[l],
            'conv_ln_b': conv_ln_b[l], 'w_conv_pw': w_conv_pw[l], 'w_out': w_out[l],
            'w_mlp1': w_mlp1[l], 'w_mlp2': w_mlp2[l],
        }
        xp, (k_l, v_l) = trunk_layer(xp, cvec_ctx, None, lp)
        new_ks.append(k_l)
        new_vs.append(v_l)
        xs, _ = trunk_layer(xs, c, (cache_k[:, l], cache_v[:, l]), lp)
    new_k = jnp.stack(new_ks, axis=1)
    new_v = jnp.stack(new_vs, axis=1)
    return (xp, xs, new_k, new_v)
```

```cpp
#include <hip/hip_runtime.h>
#include <cstdio>
#include <cstdint>

namespace pg8 {
#define PG8_LAS __attribute__((address_space(3)))
typedef unsigned short bf16_t;
typedef short bf16x8 __attribute__((ext_vector_type(8)));
typedef float f32x4 __attribute__((ext_vector_type(4)));
typedef unsigned u32x4 __attribute__((ext_vector_type(4)));
constexpr int BM = 256, BK = 64, HALF = 128, HTB = HALF * BK * 2  , STAGE_BYTES = 8 * HTB, NXCD = 8, WGM = 8;

__host__ __device__ __forceinline__ int lds_byte(int r, int c) { const int st = (r >> 4) * 2 + (c >> 5), rr = r & 15, cc = c & 31, ob = rr * 64 + cc * 2; return st * 1024 + (ob ^ (((ob >> 9) & 1) << 5)); }
__host__ __device__ __forceinline__ void stage_rc(int b, int& R, int& C) { const int st = b / 1024, sb = b % 1024, swz = sb ^ (((sb >> 9) & 1) << 5); R = (st >> 1) * 16 + swz / 64; C = (st & 1) * 32 + (swz % 64) / 2; }
__host__ __device__ __forceinline__ int perm32(int rho) { const int n = rho >> 4, i = rho & 15; return 8 * (i >> 2) + 4 * n + (i & 3); }

struct Unit { int pm, pn, kt0, ktn, part; };
struct Gemm { const bf16_t* A; const bf16_t* Bt; int M, N, K; };

struct StaticOrder {
    int nM, nN, nwg, G, c, nt;
    __host__ __device__ void init(int M, int N, int K, int G_, int c_) { nM = M / BM; nN = N / BM; nwg = nM * nN; G = G_; c = c_; nt = K / BK; }
    __host__ __device__ bool next(int i, Unit& u) const {
        const long L = (long)i * G + c; if (L >= nwg) return false;
        int wgid = (int)L; { const int q = nwg / NXCD, r = nwg % NXCD, xcd = wgid % NXCD, off = wgid / NXCD; wgid = (xcd < r ? xcd * (q + 1) : r * (q + 1) + (xcd - r) * q) + off; }
        const int nig = WGM * nN, gid = wgid / nig, fm = gid * WGM, gsz = (nM - fm) < WGM ? (nM - fm) : WGM;
        u.pm = fm + ((wgid % nig) % gsz); u.pn = (wgid % nig) / gsz; u.kt0 = 0; u.ktn = nt; u.part = 0; return true;
    }
    __device__ __forceinline__ void a_ready(const Unit&) const {}
    __device__ __forceinline__ void done(const Unit&) const {}
};
struct OneUnit {
    int pm, pn, kt0, nt; bool has;
    __device__ bool next(int i, Unit& u) const { if (i != 0 || !has) return false; u.pm = pm; u.pn = pn; u.kt0 = kt0; u.ktn = nt; u.part = 0; return true; }
    __device__ __forceinline__ void a_ready(const Unit&) const {}
    __device__ __forceinline__ void done(const Unit&) const {}
};

struct SplitOrder {
    int c, nt;
    __device__ bool next(int i, Unit& u) const {
        if (i > 1) return false;
        const int w = (c & 7) * 32 + (c >> 3);
        if (i == 0) { u.pm = w >> 3; u.pn = w & 7; u.kt0 = 0; u.ktn = nt; u.part = 0; }
        else { const int kh = w >> 7, t = w & 127; u.pm = 32 + (t >> 3); u.pn = t & 7; u.kt0 = kh * (nt >> 1); u.ktn = nt >> 1; u.part = kh; }
        return true;
    }
    __device__ __forceinline__ void a_ready(const Unit&) const {}
    __device__ __forceinline__ void done(const Unit&) const {}
};
struct P1Order {
    int c, nt;
    __device__ bool next(int i, Unit& u) const {
        if (i > 2) return false;
        if (i < 2) { const int L = i * 256 + c; const int wgid = (L & 7) * 64 + (L >> 3);
            if (wgid < 384) { const int gid = wgid / 96, rr = wgid % 96; u.pm = 8 * gid + (rr & 7); u.pn = rr >> 3; }
            else { const int w2 = wgid - 384, gid = w2 >> 6, rr = w2 & 63; u.pm = 32 + 8 * gid + (rr & 7); u.pn = rr >> 3; }
            u.kt0 = 0; u.ktn = nt; u.part = 0; }
        else { const int x = c & 7, j = c >> 3, kq = x & 3;
            u.pm = 32 + 8 * (x >> 2) + (j & 7); u.pn = 8 + (j >> 3); u.kt0 = kq * (nt >> 2); u.ktn = nt >> 2; u.part = 1 + kq; }
        return true;
    }
    __device__ __forceinline__ void a_ready(const Unit&) const {}
    __device__ __forceinline__ void done(const Unit&) const {}
};
typedef float f32x2_t __attribute__((ext_vector_type(2))); typedef __bf16 bf16x2_t __attribute__((ext_vector_type(2)));
__device__ __forceinline__ unsigned cvt_pk_bf16(float lo, float hi) { f32x2_t v = {lo, hi}; bf16x2_t b = __builtin_convertvector(v, bf16x2_t); return __builtin_bit_cast(unsigned, b); }

struct EpiF32 {
    static constexpr bool PERM = false, AFTER_DRAIN = false;
    float* C; float* C1; int ldc;
    __device__ __forceinline__ void operator()(const f32x4 (&acc)[2][2][4][2], const Unit& u, int wr, int wc, int fr, int fq) const {
        const int row0 = (u.part ? (u.pm - 32) : u.pm) * BM + wr * 64 + fr, col0 = u.pn * BM + wc * 32 + 4 * fq;
        float* base = u.part ? C1 : C;
#pragma unroll
        for (int ai = 0; ai < 2; ++ai)
#pragma unroll
            for (int m = 0; m < 4; ++m) { float* rowp = base + (size_t)(row0 + ai * HALF + m * 16) * ldc + col0;
#pragma unroll
                for (int bj = 0; bj < 2; ++bj)
#pragma unroll
                    for (int n = 0; n < 2; ++n) *(f32x4*)(rowp + bj * HALF + n * 16) = acc[ai][bj][m][n]; }
    }
};
template <int ACT, bool KV> struct EpiB {
    static constexpr bool PERM = true, AFTER_DRAIN = false;
    bf16_t* O; int ldc; float* nk; float* nv; int layer;
    bf16_t* O1; int ldc1; size_t pstride; int pcol0;
    __device__ __forceinline__ void operator()(const f32x4 (&acc)[2][2][4][2], const Unit& u, int wr, int wc, int fr, int fq) const {
        const int rloc = wr * 64 + fr, row0 = (u.part ? (u.pm - 32) : u.pm) * BM + rloc, cloc = wc * 32 + 8 * fq, col0 = u.pn * BM + cloc - (u.part ? pcol0 : 0);
        bf16_t* base = u.part ? O1 + (size_t)(u.part - 1) * pstride : O; const int ld = u.part ? ldc1 : ldc;
        float* kvp = nullptr;
        if (KV) { if (u.pm < 32 && (u.pn == 4 || u.pn == 5)) kvp = (u.pn == 4 ? nk : nv) + ((size_t)(u.pm * 4 + layer) * 256 + rloc) * 256 + cloc; }
#pragma unroll
        for (int ai = 0; ai < 2; ++ai)
#pragma unroll
            for (int m = 0; m < 4; ++m) { bf16_t* rowp = base + (size_t)(row0 + ai * HALF + m * 16) * ld + col0;
#pragma unroll
                for (int bj = 0; bj < 2; ++bj) { f32x4 v0 = acc[ai][bj][m][0], v1 = acc[ai][bj][m][1];
                    if (ACT == 1) {
#pragma unroll
                        for (int j = 0; j < 4; ++j) { const float a = fmaxf(v0[j], 0.f), b = fmaxf(v1[j], 0.f); v0[j] = a * a; v1[j] = b * b; } }
                    u32x4 w; w.x = cvt_pk_bf16(v0[0], v0[1]); w.y = cvt_pk_bf16(v0[2], v0[3]); w.z = cvt_pk_bf16(v1[0], v1[1]); w.w = cvt_pk_bf16(v1[2], v1[3]);
                    *(u32x4*)(rowp + bj * HALF) = w;
                    if (KV) { if (kvp) { float* p = kvp + (size_t)(ai * HALF + m * 16) * 256 + bj * HALF; *(f32x4*)p = v0; *(f32x4*)(p + 4) = v1; } }
                } }
    }
};

template <class Epi, class Sched, bool ALIGN_EPI = false, bool SP2 = false>
__device__ __forceinline__ void gemm_phase(PG8_LAS unsigned char* lds, const Gemm g, const Sched& S, const Epi& E) {
    int tid_ = threadIdx.x; asm volatile("" : "+v"(tid_));
    const int tid = tid_, wid = __builtin_amdgcn_readfirstlane(tid >> 6), lane = tid & 63, wr = wid >> 2, wc = wid & 3, fr = lane & 15, fq = lane >> 4;
    const int K = g.K;
    unsigned voffA[2], voffB[2];
#pragma unroll
    for (int i = 0; i < 2; ++i) { int R, C; stage_rc(tid * 16 + i * 8192, R, C); const int Rb = Epi::PERM ? ((R & ~31) + perm32(R & 31)) : R;
        voffA[i] = (unsigned)(R * K + C) * 2u; voffB[i] = (unsigned)(Rb * K + C) * 2u; }
    const size_t kstep = (size_t)(BK * 2);
    const size_t hstep = (size_t)HALF * K * 2;
    const size_t tstep = 2 * hstep;
    const unsigned ldsw = (unsigned)wid * 1024u;
    const int aoff = lds_byte(wr * 64 + fr, fq * 8), boff = lds_byte(wc * 32 + fr, fq * 8);
#define PG8_SA(b, h) (((b) * 2 + (h)) * HTB)
#define PG8_SB(b, h) ((4 + (b) * 2 + (h)) * HTB)
#define PG8_STAGE(bufoff, gbase, voff) do { _Pragma("unroll") for (int _i = 0; _i < 2; ++_i) \
        __builtin_amdgcn_global_load_lds((const unsigned*)((const char*)(gbase) + (voff)[_i]), (PG8_LAS unsigned*)(lds + (bufoff) + ldsw + _i * 8192), 16, 0, 0); } while (0)
#define PG8_LDA(dst, b, h) do { _Pragma("unroll") for (int m = 0; m < 4; ++m) _Pragma("unroll") for (int k = 0; k < 2; ++k) dst[m][k] = *(const PG8_LAS bf16x8*)(lds + PG8_SA(b, h) + aoff + m * 2048 + k * 1024); } while (0)
#define PG8_LDB(dst, b, h) do { _Pragma("unroll") for (int n = 0; n < 2; ++n) _Pragma("unroll") for (int k = 0; k < 2; ++k) dst[n][k] = *(const PG8_LAS bf16x8*)(lds + PG8_SB(b, h) + boff + n * 2048 + k * 1024); } while (0)
#define PG8_MMA(ai, bj, At, Bt) do { __builtin_amdgcn_s_setprio(1); _Pragma("unroll") for (int m = 0; m < 4; ++m) _Pragma("unroll") for (int n = 0; n < 2; ++n) _Pragma("unroll") for (int k = 0; k < 2; ++k) \
        acc[ai][bj][m][n] = __builtin_amdgcn_mfma_f32_16x16x32_bf16(Bt[n][k], At[m][k], acc[ai][bj][m][n], 0, 0, 0); __builtin_amdgcn_s_setprio(0); } while (0)
#define PG8_WAIT_V(n) asm volatile("s_waitcnt vmcnt(" #n ")" ::: "memory")
#define PG8_WAIT_L(n) asm volatile("s_waitcnt lgkmcnt(" #n ")" ::: "memory")
#define PG8_BAR __builtin_amdgcn_s_barrier()
#define PG8_SCHED __builtin_amdgcn_sched_barrier(0)
    Unit cur, nxt; int ui = 0;
    if (!S.next(0, cur)) return;
    f32x4 acc[2][2][4][2];
#pragma unroll
    for (int a = 0; a < 2; ++a)
#pragma unroll
        for (int b = 0; b < 2; ++b)
#pragma unroll
            for (int m = 0; m < 4; ++m)
#pragma unroll
                for (int n = 0; n < 2; ++n) acc[a][b][m][n] = (f32x4){0.f, 0.f, 0.f, 0.f};
    bf16x8 At[4][2], B0[2][2], B1[2][2];
    const char* cA = (const char*)g.A + (size_t)cur.pm * tstep + (size_t)cur.kt0 * kstep; const char* cB = (const char*)g.Bt + (size_t)cur.pn * tstep + (size_t)cur.kt0 * kstep;
    S.a_ready(cur);
    if constexpr (SP2) {
        PG8_STAGE(PG8_SB(0, 0), cB, voffB); PG8_STAGE(PG8_SB(0, 1), cB + hstep, voffB); PG8_STAGE(PG8_SA(0, 0), cA, voffA); PG8_STAGE(PG8_SA(0, 1), cA + hstep, voffA);
        if (wr == 1) PG8_BAR;
        PG8_WAIT_V(2); PG8_BAR;
        PG8_STAGE(PG8_SB(1, 0), cB + kstep, voffB); PG8_STAGE(PG8_SA(1, 0), cA + kstep, voffA); PG8_STAGE(PG8_SB(1, 1), cB + hstep + kstep, voffB);
        PG8_WAIT_V(6); PG8_BAR;
    } else {
        PG8_STAGE(PG8_SB(0, 0), cB, voffB); PG8_STAGE(PG8_SA(0, 0), cA, voffA); PG8_STAGE(PG8_SB(0, 1), cB + hstep, voffB); PG8_STAGE(PG8_SA(0, 1), cA + hstep, voffA);
        if (wr == 1) PG8_BAR;
        PG8_WAIT_V(4); PG8_BAR;
        PG8_STAGE(PG8_SB(1, 0), cB + kstep, voffB); PG8_STAGE(PG8_SA(1, 0), cA + kstep, voffA); PG8_STAGE(PG8_SB(1, 1), cB + hstep + kstep, voffB);
        PG8_WAIT_V(6); PG8_BAR;
    }
    for (;;) {
        const bool has_next = S.next(ui + 1, nxt);
        const char* nA = has_next ? (const char*)g.A + (size_t)nxt.pm * tstep + (size_t)nxt.kt0 * kstep : cA; const char* nB = has_next ? (const char*)g.Bt + (size_t)nxt.pn * tstep + (size_t)nxt.kt0 * kstep : cB;
        const int nt = cur.ktn;
        for (int t = 0; t < nt; t += 2) {
            const bool last = (t == nt - 2);
            const char* a1 = cA + (size_t)(t + 1) * kstep;
            const char* a2 = last ? nA : cA + (size_t)(t + 2) * kstep; const char* b2 = last ? nB : cB + (size_t)(t + 2) * kstep;
            const char* a3 = a2 + kstep; const char* b3 = b2 + kstep;
            if (last && has_next) S.a_ready(nxt);
            if constexpr (SP2) {
            PG8_LDB(B0, 0, 0); PG8_LDB(B1, 0, 1); PG8_SCHED; PG8_LDA(At, 0, 0); PG8_STAGE(PG8_SA(1, 1), a1 + hstep, voffA);
            PG8_WAIT_V(8); PG8_WAIT_L(0); PG8_BAR; PG8_MMA(0, 0, At, B0); PG8_MMA(0, 1, At, B1); PG8_BAR; PG8_SCHED;
            PG8_LDA(At, 0, 1); PG8_STAGE(PG8_SB(0, 0), b2, voffB); PG8_STAGE(PG8_SB(0, 1), b2 + hstep, voffB); PG8_STAGE(PG8_SA(0, 0), a2, voffA);
            PG8_WAIT_V(8); PG8_WAIT_L(0); PG8_BAR; PG8_MMA(1, 0, At, B0); PG8_MMA(1, 1, At, B1); PG8_BAR; PG8_SCHED;
            PG8_LDB(B0, 1, 0); PG8_LDB(B1, 1, 1); PG8_SCHED; PG8_LDA(At, 1, 0); PG8_STAGE(PG8_SA(0, 1), a2 + hstep, voffA);
            PG8_WAIT_V(8); PG8_WAIT_L(0); PG8_BAR; PG8_MMA(0, 0, At, B0); PG8_MMA(0, 1, At, B1); PG8_BAR; PG8_SCHED;
            PG8_LDA(At, 1, 1); PG8_STAGE(PG8_SB(1, 0), b3, voffB); PG8_STAGE(PG8_SB(1, 1), b3 + hstep, voffB); PG8_STAGE(PG8_SA(1, 0), a3, voffA);
            PG8_WAIT_V(8); PG8_WAIT_L(0); PG8_BAR; PG8_MMA(1, 0, At, B0); PG8_MMA(1, 1, At, B1); PG8_BAR; PG8_SCHED;
            } else {
            PG8_LDB(B0, 0, 0); PG8_SCHED; PG8_LDA(At, 0, 0); PG8_STAGE(PG8_SA(1, 1), a1 + hstep, voffA);
            PG8_WAIT_L(8); PG8_BAR; PG8_WAIT_L(0); PG8_MMA(0, 0, At, B0); PG8_BAR; PG8_SCHED;
            PG8_LDB(B1, 0, 1); PG8_STAGE(PG8_SB(0, 0), b2, voffB);
            PG8_BAR; PG8_WAIT_L(0); PG8_MMA(0, 1, At, B1); PG8_BAR;
            PG8_LDA(At, 0, 1); PG8_STAGE(PG8_SA(0, 0), a2, voffA);
            PG8_BAR; PG8_WAIT_L(0); PG8_MMA(1, 0, At, B0); PG8_BAR; PG8_SCHED;
            PG8_STAGE(PG8_SB(0, 1), b2 + hstep, voffB);
            PG8_WAIT_V(6); PG8_BAR; PG8_MMA(1, 1, At, B1); PG8_BAR;
            PG8_LDB(B0, 1, 0); PG8_SCHED; PG8_LDA(At, 1, 0); PG8_STAGE(PG8_SA(0, 1), a2 + hstep, voffA);
            PG8_WAIT_L(8); PG8_BAR; PG8_WAIT_L(0); PG8_MMA(0, 0, At, B0); PG8_BAR; PG8_SCHED;
            PG8_LDB(B1, 1, 1); PG8_STAGE(PG8_SB(1, 0), b3, voffB);
            PG8_BAR; PG8_WAIT_L(0); PG8_MMA(0, 1, At, B1); PG8_BAR;
            PG8_LDA(At, 1, 1); PG8_STAGE(PG8_SA(1, 0), a3, voffA);
            PG8_BAR; PG8_WAIT_L(0); PG8_MMA(1, 0, At, B0); PG8_BAR; PG8_SCHED;
            PG8_STAGE(PG8_SB(1, 1), b3 + hstep, voffB);
            PG8_WAIT_V(6); PG8_BAR; PG8_MMA(1, 1, At, B1); PG8_BAR;
            }
        }
        if constexpr (ALIGN_EPI) { if (wr == 0) PG8_BAR; }
        if constexpr (!Epi::AFTER_DRAIN) { E(acc, cur, wr, wc, fr, fq); S.done(cur); }
        if (!has_next) break;
#pragma unroll
        for (int a = 0; a < 2; ++a)
#pragma unroll
            for (int b = 0; b < 2; ++b)
#pragma unroll
                for (int m = 0; m < 4; ++m)
#pragma unroll
                    for (int n = 0; n < 2; ++n) acc[a][b][m][n] = (f32x4){0.f, 0.f, 0.f, 0.f};
        cur = nxt; cA = nA; cB = nB; ++ui;
        if constexpr (ALIGN_EPI) { if (wr == 1) PG8_BAR; }
    }
    PG8_WAIT_V(0);
    if constexpr (!ALIGN_EPI) { if (wr == 0) PG8_BAR; }
    PG8_BAR;
#undef PG8_SA
#undef PG8_SB
#undef PG8_STAGE
#undef PG8_LDA
#undef PG8_LDB
#undef PG8_MMA
#undef PG8_WAIT_V
#undef PG8_WAIT_L
#undef PG8_BAR
#undef PG8_SCHED
}
}

#ifndef PHASE_MASK
#define PHASE_MASK 0xFFFF
#endif
#define PH(k) ((PHASE_MASK >> (k)) & 1)
#ifndef DUP_MASK
#define DUP_MASK 0
#endif
#define DUPN(k) (1 + ((DUP_MASK >> (k)) & 1))
constexpr int NWAVES = 8;
constexpr int DM = 2048, NB_P = 32, SEQ_P = 256, DEPTH = 4, NB_S = 2, SEQ_S = 2048, PAST = 512;
constexpr int MP = NB_P * SEQ_P, MS = NB_S * SEQ_S, M = MP + MS;
constexpr int INW = 3072, DFF = 8192, HD = 64;
constexpr int OK_ = 1024, OV_ = 1280, OPU = 1536, OCA = 2048, OCG = 2560;
constexpr int ADA = 6 * DM;
constexpr float EPS = 1e-6f;
constexpr float LOG2E = 1.4426950408889634f;
constexpr size_t OUT_Y = 0, OUT_NK = (size_t)M * DM, OUT_NV = OUT_NK + (size_t)NB_P * DEPTH * SEQ_P * 256;

constexpr size_t MiB = 1u << 20;
constexpr size_t WS_CTL = 0, CTL_ZERO_BYTES = 1 * MiB;
constexpr size_t WS_MODS = 1 * MiB;
constexpr size_t WS_ROPE = 2 * MiB;
constexpr size_t WS_MODP = 3 * MiB;
constexpr size_t WS_KC = 8 * MiB;
constexpr size_t WS_VC = 10 * MiB;
constexpr size_t WS_WBD = 12 * MiB;
constexpr size_t WS_WOT2 = 20 * MiB;
constexpr size_t WS_WIN = 36 * MiB;
constexpr size_t WS_WOUT = 84 * MiB;
constexpr size_t WS_W1 = 116 * MiB;
constexpr size_t WS_W2 = 244 * MiB;
constexpr size_t WS_H = 372 * MiB;
constexpr size_t WS_Z = 420 * MiB;
constexpr size_t WS_MIXCAT = 492 * MiB;
constexpr size_t WS_MIX = 540 * MiB;
constexpr size_t WS_U = 636 * MiB;
constexpr size_t WS_MIX2 = 828 * MiB;
constexpr size_t WS_ZP = 844 * MiB;
constexpr size_t WS_XB = 876 * MiB;
constexpr size_t WS_END = 924 * MiB;
constexpr int CW_BAR = 4096, CW_GEMV = 1024;

constexpr int LDS_BYTES = 147456;
constexpr int MISC_OFF = 135168;

#define GAS __attribute__((address_space(1)))
#define LAS __attribute__((address_space(3)))
typedef unsigned short bf16;
typedef unsigned v4u __attribute__((ext_vector_type(4)));
typedef unsigned v2u __attribute__((ext_vector_type(2)));
typedef float f32x4 __attribute__((ext_vector_type(4)));
typedef float f32x16 __attribute__((ext_vector_type(16)));
typedef short bf16x8 __attribute__((ext_vector_type(8)));
typedef short s16x4 __attribute__((ext_vector_type(4)));
#define LDS_WAIT() asm volatile("s_waitcnt lgkmcnt(0)" ::: "memory")
#define VM_WAIT() asm volatile("s_waitcnt vmcnt(0)" ::: "memory")
__device__ __forceinline__ unsigned pk2(float lo, float hi) { return pg8::cvt_pk_bf16(lo, hi); }
__device__ __forceinline__ float bf2f(bf16 b) { return __uint_as_float((unsigned)b << 16); }
__device__ __forceinline__ float bflo(unsigned w) { return __uint_as_float(w << 16); }
__device__ __forceinline__ float bfhi(unsigned w) { return __uint_as_float(w & 0xffff0000u); }

#define XB_TMO      128
#define XB_XCNT(j)  (256  + 64 * (j))
#define XB_XSUB(j)  (1280 + 64 * (j))
#define XB_XGEN(j)  (2304 + 64 * (j))
#define XB_TOP      3328
#define XB_TOPGEN   3392
#define XCD_BAR_WORDS 3456
#define XB_SPIN_CAP (1u << 18)
__device__ __forceinline__ unsigned xb_ld(unsigned* p)              { return __hip_atomic_load(p, __ATOMIC_RELAXED, __HIP_MEMORY_SCOPE_AGENT); }
__device__ __forceinline__ unsigned xb_add(unsigned* p, unsigned v) { return __hip_atomic_fetch_add(p, v, __ATOMIC_RELAXED, __HIP_MEMORY_SCOPE_AGENT); }
__device__ __forceinline__ unsigned xb_xcc_id() { return (unsigned)__builtin_amdgcn_s_getreg((3 << 11) | 20) & 0xFu; }
#define XB_SPIN(cond, bar) do { unsigned _sp = 0; while (cond) { __builtin_amdgcn_s_sleep(1); \
    if ((++_sp & 255u) == 0u) { if (xb_ld(&(bar)[XB_TMO])) break; if (_sp > XB_SPIN_CAP) { atomicAdd(&(bar)[XB_TMO], 1u); break; } } } } while (0)
struct XcdBarrier { unsigned* bar; unsigned x; volatile LAS unsigned* st; };
__device__ __forceinline__ XcdBarrier xcd_barrier_post(unsigned* bar, volatile LAS unsigned* st) {
    XcdBarrier b; b.bar = bar; b.x = xb_xcc_id(); b.st = st;
    if (threadIdx.x == 0) (void)xb_add(&bar[XB_XCNT(b.x)], 1u);
    return b;
}
__device__ __forceinline__ void xcd_barrier_complete(unsigned* bar, unsigned x, unsigned& nloc, unsigned& nx) {
    const unsigned G = gridDim.x * gridDim.y * gridDim.z;
    unsigned sum, cnt, mine, sp = 0u;
    for (;;) {
        sum = 0u; cnt = 0u; mine = 0u;
#pragma unroll
        for (unsigned j = 0; j < 16; ++j) { const unsigned c = xb_ld(&bar[XB_XCNT(j)]); sum += c; cnt += (c > 0u) ? 1u : 0u; mine = (j == x) ? c : mine; }
        if (sum == G) break;
        __builtin_amdgcn_s_sleep(1);
        if ((++sp & 255u) == 0u) { if (xb_ld(&bar[XB_TMO])) break; if (sp > XB_SPIN_CAP) { atomicAdd(&bar[XB_TMO], 1u); break; } }
    }
    nloc = mine > 0u ? mine : 1u; nx = cnt > 0u ? cnt : 1u;
}
__device__ __forceinline__ void xcd_barrier_leader(const XcdBarrier& b) {
    {
        unsigned* bar = b.bar;
        __builtin_amdgcn_s_waitcnt(0);
        unsigned nloc = b.st[0], nx = b.st[1];
        if (nloc == 0u) { xcd_barrier_complete(bar, b.x, nloc, nx); b.st[0] = nloc; b.st[1] = nx; }
        const unsigned old = xb_add(&bar[XB_XSUB(b.x)], 1u);
        const unsigned gen = old / nloc;
        if (old + 1u == (gen + 1u) * nloc) {
            __builtin_amdgcn_fence(__ATOMIC_RELEASE, "agent");
            asm volatile("s_waitcnt vmcnt(0)" ::: "memory");
            const unsigned og = xb_add(&bar[XB_TOP], 1u);
            const unsigned tg = og / nx;
            if (og + 1u == (tg + 1u) * nx) xb_add(&bar[XB_TOPGEN], 1u);
            else XB_SPIN(xb_ld(&bar[XB_TOPGEN]) == tg, bar);
            __builtin_amdgcn_fence(__ATOMIC_ACQUIRE, "agent");
            xb_add(&bar[XB_XGEN(b.x)], 1u);
            asm volatile("s_waitcnt vmcnt(0)" ::: "memory");
        } else {
            XB_SPIN(xb_ld(&bar[XB_XGEN(b.x)]) == gen, bar);
            __builtin_amdgcn_fence(__ATOMIC_ACQUIRE, "agent");
            asm volatile("s_waitcnt vmcnt(0)" ::: "memory");
        }
    }
}
__device__ __forceinline__ void xcd_barrier(const XcdBarrier& b) {
    asm volatile("s_waitcnt vmcnt(0)" ::: "memory");
    __syncthreads();
    if (threadIdx.x == 0) xcd_barrier_leader(b);
    __syncthreads();
}

struct Args { const float* in[24]; float* out; unsigned char* ws; };
struct Frame {
    LAS unsigned char* lds;
    int G, bx;
};
#define IN_(k) (A.in[k])
#define x_prompt_ IN_(0)
#define x_sample_ IN_(1)
#define cache_k_ IN_(2)
#define cache_v_ IN_(3)
#define c_ IN_(4)
#define c_ctx_ IN_(5)
#define w_ada_ IN_(6)
#define b_ada_ IN_(7)
#define g_pre1_ IN_(8)
#define g_post1_ IN_(9)
#define g_pre2_ IN_(10)
#define g_post2_ IN_(11)
#define w_in_ IN_(12)
#define sink_ IN_(13)
#define w_pool_ IN_(14)
#define pool_scale_ IN_(15)
#define conv_dw_ IN_(16)
#define conv_b_ IN_(17)
#define conv_ln_g_ IN_(18)
#define conv_ln_b_ IN_(19)
#define w_conv_pw_ IN_(20)
#define w_out_ IN_(21)
#define w_mlp1_ IN_(22)
#define w_mlp2_ IN_(23)
#define WSF(off) ((float*)(A.ws + (off)))
#define WSB(off) ((bf16*)(A.ws + (off)))
#define PHASE_IDS() int tid_ = threadIdx.x; asm volatile("" : "+v"(tid_)); const int tid = tid_, lane = tid & 63, wv = __builtin_amdgcn_readfirstlane(tid >> 6); (void)lane; (void)wv
#define DPP_F(old_, v_, ctrl_, rm_) __builtin_bit_cast(float, __builtin_amdgcn_update_dpp(__builtin_bit_cast(int, (float)(old_)), __builtin_bit_cast(int, (float)(v_)), (ctrl_), (rm_), 0xf, false))
__device__ __forceinline__ float wave_sum(float v) {
    v += DPP_F(0.f, v, 0xB1, 0xf);
    v += DPP_F(0.f, v, 0x4E, 0xf);
    v += DPP_F(0.f, v, 0x124, 0xf);
    v += DPP_F(0.f, v, 0x128, 0xf);
    v += DPP_F(0.f, v, 0x142, 0xa);
    v += DPP_F(0.f, v, 0x143, 0xc);
    return __builtin_bit_cast(float, __builtin_amdgcn_readlane(__builtin_bit_cast(int, v), 63));
}

__device__ __forceinline__ void tr_tile(const float* W, int N, bf16* WT, int ldt, int k0, int n0, LAS float* scr, int lane) {
    const int kq = lane >> 4, n4 = (lane & 15) * 4;
#pragma unroll 4
    for (int i = 0; i < 16; ++i) { const int kk = 4 * i + kq; const f32x4 v = *(const f32x4*)(W + (size_t)(k0 + kk) * N + n0 + n4);
        LAS float* d = scr + kk * 65 + n4; d[0] = v[0]; d[1] = v[1]; d[2] = v[2]; d[3] = v[3]; }
    LDS_WAIT(); asm volatile("" ::: "memory");
    const int c = lane & 7;
#pragma unroll
    for (int j = 0; j < 8; ++j) { const int n = (lane >> 3) + 8 * j; const LAS float* s = scr + (8 * c) * 65 + n;
        v4u o; o.x = pk2(s[0 * 65], s[1 * 65]); o.y = pk2(s[2 * 65], s[3 * 65]); o.z = pk2(s[4 * 65], s[5 * 65]); o.w = pk2(s[6 * 65], s[7 * 65]);
        *(v4u*)(WT + (size_t)(n0 + n) * ldt + k0 + 8 * c) = o; }
    LDS_WAIT(); asm volatile("" ::: "memory");
}
__device__ __forceinline__ void p0a(Frame& F, const Args& A) {
    PHASE_IDS();
    {
        LAS float* S = (LAS float*)F.lds;
        LAS float* RED = (LAS float*)(F.lds + 24576);
        for (int i = tid; i < 3 * DM; i += NWAVES * 64) { const int cv = i / DM, k = i % DM; const float v = (cv == 0) ? c_ctx_[k] : c_[(cv - 1) * DM + k]; S[i] = v / (1.f + expf(-v)); }
        __syncthreads();
        for (int rp_ = 0; rp_ < DUPN(14); ++rp_) for (int it = F.bx; it < DEPTH * 48 * 8; it += F.G) {
            const int l = it / 384, rem = it % 384, cc = rem >> 3, kp = rem & 7;
            const int kb = kp * 256 + wv * 32;
            const float* W = w_ada_ + ((size_t)l * DM + kb) * ADA + cc * 256 + lane * 4;
            f32x4 a0 = {0.f, 0.f, 0.f, 0.f}, a1 = a0, a2 = a0;
#pragma unroll 8
            for (int r = 0; r < 32; ++r) { const f32x4 w = *(const f32x4*)(W + (size_t)r * ADA); const float s0 = S[kb + r], s1 = S[DM + kb + r], s2 = S[2 * DM + kb + r];
                a0 += w * s0; a1 += w * s1; a2 += w * s2; }
            *(LAS f32x4*)(RED + (wv * 3 + 0) * 256 + lane * 4) = a0; *(LAS f32x4*)(RED + (wv * 3 + 1) * 256 + lane * 4) = a1; *(LAS f32x4*)(RED + (wv * 3 + 2) * 256 + lane * 4) = a2;
            __syncthreads();
            for (int o = tid; o < 768; o += NWAVES * 64) { const int cv = o >> 8, col = o & 255; float s = 0.f;
#pragma unroll
                for (int w8 = 0; w8 < 8; ++w8) s += RED[(w8 * 3 + cv) * 256 + col];
                WSF(WS_MODP)[((size_t)(kp * DEPTH + l) * 3 + cv) * ADA + cc * 256 + col] = s; }
            __syncthreads();
        }
    }
    asm volatile("s_waitcnt vmcnt(0)" ::: "memory");
    __syncthreads();
    if (tid == 0) { __builtin_amdgcn_fence(__ATOMIC_RELEASE, "agent"); (void)xb_add((unsigned*)(A.ws + WS_CTL) + CW_GEMV, 1u); }
    {
        LAS float* scr = (LAS float*)(F.lds + wv * 16640);
        const int gw = F.bx * NWAVES + wv, NGW = F.G * NWAVES;
        constexpr int T_IN = 32 * 48, T_OUT = 32 * 32, T_1 = 32 * 128, T_2 = 128 * 32, T_L = T_IN + T_OUT + T_1 + T_2;
#define TR_DEC(r_, nnb_, kb_, nb_) do { const int blk_ = (r_) >> 3, in_ = (r_) & 7, bn_ = blk_ % ((nnb_) / 4), bk_ = blk_ / ((nnb_) / 4); kb_ = 2 * bk_ + (in_ >> 2); nb_ = 4 * bn_ + (in_ & 3); } while (0)
        for (int rp_ = 0; rp_ < DUPN(15); ++rp_) for (int it = gw; it < DEPTH * T_L; it += NGW) {
            const int l = it / T_L; int r = it % T_L;
            if (r < T_IN) { int kb, nb; TR_DEC(r, 48, kb, nb); tr_tile(w_in_ + (size_t)l * DM * INW, INW, WSB(WS_WIN) + (size_t)l * INW * DM, DM, kb * 64, nb * 64, scr, lane); continue; } r -= T_IN;
            if (r < T_OUT) { int kb, nb; TR_DEC(r, 32, kb, nb);
                if (kb < 16) tr_tile(w_out_ + (size_t)l * DM * DM, DM, WSB(WS_WOUT) + (size_t)l * DM * DM, DM, kb * 64, nb * 64, scr, lane);
                else tr_tile(w_out_ + (size_t)l * DM * DM + (size_t)1024 * DM, DM, WSB(WS_WOT2) + (size_t)l * DM * 1024, 1024, (kb - 16) * 64, nb * 64, scr, lane);
                continue; } r -= T_OUT;
            if (r < T_1) { int kb, nb; TR_DEC(r, 128, kb, nb); tr_tile(w_mlp1_ + (size_t)l * DM * DFF, DFF, WSB(WS_W1) + (size_t)l * DFF * DM, DM, kb * 64, nb * 64, scr, lane); continue; } r -= T_1;
            { int kb, nb; TR_DEC(r, 32, kb, nb); tr_tile(w_mlp2_ + (size_t)l * DFF * DM, DM, WSB(WS_W2) + (size_t)l * DM * DFF, DFF, kb * 64, nb * 64, scr, lane); }
        }
    }
    const int gt = F.bx * (NWAVES * 64) + tid, NGT = F.G * NWAVES * 64;
    for (int i = gt; i < 2 * 262144; i += NGT) {
        const int which = i >> 18, o4 = i & 262143;
        const int d4 = o4 & 15, key = (o4 >> 4) & 511, kvh = (o4 >> 13) & 3, bl = o4 >> 15;
        const float* src = (which ? cache_v_ : cache_k_) + (((size_t)bl * 512 + key) * 4 + kvh) * 64 + d4 * 4;
        const f32x4 v = *(const f32x4*)src; v2u o; o.x = pk2(v[0], v[1]); o.y = pk2(v[2], v[3]);
        *(v2u*)((which ? WSB(WS_VC) : WSB(WS_KC)) + (size_t)o4 * 4) = o;
    }
    for (int i = gt; i < 1536; i += NGT) {
        const int fi = i & 15, p = (i < 512) ? (i >> 4) : ((i - 512) >> 4);
        const float inv = 1.0f / powf(10000.0f, (float)fi * (1.0f / 16.0f));
        const float ang = (float)p * inv;
        const float kq = rintf(ang * 0.15915494309189535f);
        float rr = fmaf(-kq, 6.2831854820251465f, ang); rr = fmaf(-kq, -1.7484555e-7f, rr);
        const float cs = cosf(rr), sn = sinf(rr);
        if (i < 512) { WSF(WS_ROPE)[i] = cs; WSF(WS_ROPE)[512 + i] = sn; } else { WSF(WS_ROPE)[1024 + (i - 512)] = cs; WSF(WS_ROPE)[2048 + (i - 512)] = sn; }
    }
    for (int i = gt; i < DEPTH * 1024 * 128; i += NGT) {
        const int j8 = (i & 127) * 8, k = (i >> 7) & 1023, l = i >> 17;
        float v[8];
#pragma unroll
        for (int e = 0; e < 8; ++e) v[e] = 0.f;
        if (k < 512) { const int g = k >> 7; if ((j8 >> 7) == g) { const float* wp = w_pool_ + (((size_t)l * 4 + g) * 128 + (k & 127)) * 128 + (j8 & 127); const float* ps = pool_scale_ + l * 512 + j8;
#pragma unroll
                for (int e = 0; e < 8; ++e) v[e] = wp[e] * ps[e]; } }
        else if (j8 >= 512) { const float* wp = w_conv_pw_ + ((size_t)l * 512 + (k - 512)) * 512 + (j8 - 512);
#pragma unroll
            for (int e = 0; e < 8; ++e) v[e] = wp[e]; }
        v4u o; o.x = pk2(v[0], v[1]); o.y = pk2(v[2], v[3]); o.z = pk2(v[4], v[5]); o.w = pk2(v[6], v[7]);
        *(v4u*)(WSB(WS_WBD) + ((size_t)l * 1024 + k) * 1024 + j8) = o;
    }
    if (tid == 0) { unsigned* cnt = (unsigned*)(A.ws + WS_CTL) + CW_GEMV; unsigned sp = 0u;
        while (xb_ld(cnt) < (unsigned)F.G) { __builtin_amdgcn_s_sleep(1); if (++sp > (1u << 22)) break; }
        __builtin_amdgcn_fence(__ATOMIC_ACQUIRE, "agent"); }
    __syncthreads();
    for (int i = gt; i < DEPTH * 3 * ADA; i += NGT) { const int j = i % ADA, lc = i / ADA, l = lc / 3, cv = lc % 3;
        float sacc = b_ada_[(size_t)l * ADA + j];
#pragma unroll
        for (int kp = 0; kp < 8; ++kp) sacc += WSF(WS_MODP)[((size_t)(kp * DEPTH + l) * 3 + cv) * ADA + j];
        WSF(WS_MODS)[i] = sacc; }
}

template <bool PART> __device__ __forceinline__ float mod_val(Frame& F, const Args& A, int l, int cv, int j) {
    if (!PART) return WSF(WS_MODS)[((size_t)l * 3 + cv) * ADA + j];
    float s = b_ada_[(size_t)l * ADA + j];
#pragma unroll
    for (int kp = 0; kp < 8; ++kp) s += WSF(WS_MODP)[((size_t)(kp * DEPTH + l) * 3 + cv) * ADA + j];
    return s;
}
template <int MODE, bool PART, int STAGE = 0>
__device__ __forceinline__ void thin_phase(Frame& F, const Args& A, const float* gpost, int gate_off, int l_gate, const float* gpre, int sc_off, int sh_off, int l_mod, bool x_from_inputs, const XcdBarrier* barp = nullptr) {
    PHASE_IDS();
    LAS float* PA = (LAS float*)F.lds; LAS float* PB = PA + 3 * DM; LAS float* PC = PB + 3 * DM;
    if (STAGE == 4) {
        asm volatile("s_waitcnt vmcnt(0)" ::: "memory");
        __syncthreads();
        if (wv == 0) { if (tid == 0) xcd_barrier_leader(*barp); }
        else {
#pragma unroll
            for (int k = 0; k < 14; ++k) { const int i = (tid - 64) + 448 * k; if (i < 3 * DM) { const int cv = i / DM, c = i % DM;
                if (MODE != 0) PA[i] = mod_val<PART>(F, A, l_gate, cv, gate_off + c) * gpost[c];
                if (MODE != 2) { PB[i] = gpre[c] * (1.f + mod_val<PART>(F, A, l_mod, cv, sc_off + c)); PC[i] = mod_val<PART>(F, A, l_mod, cv, sh_off + c); } } }
        }
    }
    if (STAGE != 2 && STAGE != 4) {
#pragma unroll
    for (int k = 0; k < 12; ++k) { const int i = tid + 512 * k, cv = i / DM, c = i % DM;
        if (MODE != 0) PA[i] = mod_val<PART>(F, A, l_gate, cv, gate_off + c) * gpost[c];
        if (MODE != 2) { PB[i] = gpre[c] * (1.f + mod_val<PART>(F, A, l_mod, cv, sc_off + c)); PC[i] = mod_val<PART>(F, A, l_mod, cv, sh_off + c); } }
    }
    if (STAGE == 1) return;
    __syncthreads();
    const int nchk = (MODE == 0) ? (F.bx < 128 ? 2 : 4) : 3;
    for (int ci = 0; ci < nchk; ++ci) { const int ch = (MODE == 0) ? (F.bx < 128 ? 2 * F.bx + ci : 256 + 4 * (F.bx - 128) + ci) : F.bx + 256 * ci;
#pragma unroll
        for (int rr = 0; rr < 2; ++rr) {
            const int row = ch * 16 + wv * 2 + rr;
            const int cv = row < MP ? 0 : (row < MP + SEQ_S ? 1 : 2);
            f32x4 xv[8];
            if (x_from_inputs) { const float* xin = row < MP ? x_prompt_ + (size_t)row * DM : x_sample_ + (size_t)(row - MP) * DM;
#pragma unroll
                for (int j = 0; j < 8; ++j) xv[j] = *(const f32x4*)(xin + 512 * (j >> 1) + 8 * lane + 4 * (j & 1)); }
            else { const bf16* xb = WSB(WS_XB) + (size_t)row * DM;
#pragma unroll
                for (int jj = 0; jj < 4; ++jj) { const v4u w = *(const v4u*)(xb + 512 * jj + 8 * lane);
                    xv[2 * jj] = (f32x4){bflo(w.x), bfhi(w.x), bflo(w.y), bfhi(w.y)}; xv[2 * jj + 1] = (f32x4){bflo(w.z), bfhi(w.z), bflo(w.w), bfhi(w.w)}; } }
            if (MODE != 0) {
                const bf16* mp = WSB(WS_MIX) + (size_t)row * DM; f32x4 mv[8]; float ss = 0.f;
#pragma unroll
                for (int jj = 0; jj < 4; ++jj) { const v4u w = *(const v4u*)(mp + 512 * jj + 8 * lane);
                    mv[2 * jj] = (f32x4){bflo(w.x), bfhi(w.x), bflo(w.y), bfhi(w.y)}; mv[2 * jj + 1] = (f32x4){bflo(w.z), bfhi(w.z), bflo(w.w), bfhi(w.w)}; }
                if (row >= MP) { const bf16* mp2 = WSB(WS_MIX2) + (size_t)(row - MP) * DM;
#pragma unroll
                    for (int jj = 0; jj < 4; ++jj) { const v4u w = *(const v4u*)(mp2 + 512 * jj + 8 * lane);
                        mv[2 * jj] = mv[2 * jj] + (f32x4){bflo(w.x), bfhi(w.x), bflo(w.y), bfhi(w.y)}; mv[2 * jj + 1] = mv[2 * jj + 1] + (f32x4){bflo(w.z), bfhi(w.z), bflo(w.w), bfhi(w.w)}; } }
#pragma unroll
                for (int j = 0; j < 8; ++j) ss += (mv[j][0] * mv[j][0] + mv[j][1] * mv[j][1]) + (mv[j][2] * mv[j][2] + mv[j][3] * mv[j][3]);
                const float r1 = __builtin_amdgcn_rsqf(wave_sum(ss) * (1.0f / DM) + EPS);
#pragma unroll
                for (int j = 0; j < 8; ++j) { const int co = 512 * (j >> 1) + 8 * lane + 4 * (j & 1); const f32x4 pa = *(const LAS f32x4*)(PA + cv * DM + co); xv[j] = xv[j] + pa * (mv[j] * r1); }
                if (MODE == 2) { float* xo = A.out + (size_t)row * DM;
#pragma unroll
                    for (int j = 0; j < 8; ++j) *(f32x4*)(xo + 512 * (j >> 1) + 8 * lane + 4 * (j & 1)) = xv[j]; }
                else { bf16* xo = WSB(WS_XB) + (size_t)row * DM;
#pragma unroll
                    for (int jj = 0; jj < 4; ++jj) { v4u o; o.x = pk2(xv[2 * jj][0], xv[2 * jj][1]); o.y = pk2(xv[2 * jj][2], xv[2 * jj][3]); o.z = pk2(xv[2 * jj + 1][0], xv[2 * jj + 1][1]); o.w = pk2(xv[2 * jj + 1][2], xv[2 * jj + 1][3]);
                        *(v4u*)(xo + 512 * jj + 8 * lane) = o; } }
            }
            if (MODE != 2) {
                float ss = 0.f;
#pragma unroll
                for (int j = 0; j < 8; ++j) ss += (xv[j][0] * xv[j][0] + xv[j][1] * xv[j][1]) + (xv[j][2] * xv[j][2] + xv[j][3] * xv[j][3]);
                const float r2 = __builtin_amdgcn_rsqf(wave_sum(ss) * (1.0f / DM) + EPS);
                bf16* hp = WSB(WS_H) + (size_t)row * DM;
#pragma unroll
                for (int jj = 0; jj < 4; ++jj) { const int co = 512 * jj + 8 * lane;
                    const f32x4 pb0 = *(const LAS f32x4*)(PB + cv * DM + co), pb1 = *(const LAS f32x4*)(PB + cv * DM + co + 4), pc0 = *(const LAS f32x4*)(PC + cv * DM + co), pc1 = *(const LAS f32x4*)(PC + cv * DM + co + 4);
                    const f32x4 h0 = (xv[2 * jj] * r2) * pb0 + pc0, h1 = (xv[2 * jj + 1] * r2) * pb1 + pc1;
                    v4u o; o.x = pk2(h0[0], h0[1]); o.y = pk2(h0[2], h0[3]); o.z = pk2(h1[0], h1[1]); o.w = pk2(h1[2], h1[3]); *(v4u*)(hp + co) = o; }
            }
        }
    }
    __syncthreads();
}

#define MFMA32(a, b, c) __builtin_amdgcn_mfma_f32_32x32x16_bf16((a), (b), (c), 0, 0, 0)
__device__ __forceinline__ int crow(int reg, int h) { return (reg & 3) + 8 * (reg >> 2) + 4 * h; }
constexpr int KS_LD = 72, VT_LD = 136;
template <bool LAT>
__device__ __forceinline__ void attn_unit(Frame& F, const Args& A, int layer, int unit) {
    LAS bf16* Ks = (LAS bf16*)F.lds; LAS bf16* Vt = (LAS bf16*)(F.lds + 128 * KS_LD * 2);
    asm volatile("" : "+s"(unit));
    PHASE_IDS(); const int w = wv, r = lane & 31, h = lane >> 5;
    int b, kvh, tq, qpos0 = 0, nb = 0;
    if (LAT) { kvh = unit & 3; nb = (unit >> 2) & 15; b = unit >> 6; qpos0 = nb * 128 + 32 * (w & 3); tq = MP + b * SEQ_S + qpos0; }
    else { const int half = unit & 1; kvh = (unit >> 1) & 3; b = unit >> 3; tq = b * SEQ_P + half * 128 + 32 * (w & 3); }
    const int hq0 = kvh * 4 + (w >> 2);
    bf16x8 q[2][4];
#pragma unroll
    for (int t = 0; t < 2; ++t) {
        v4u qraw[4];
        { const bf16* qp = WSB(WS_Z) + (size_t)(tq + r) * INW + (hq0 + 2 * t) * 64 + 8 * h;
#pragma unroll
          for (int s = 0; s < 4; ++s) qraw[s] = *(const v4u*)(qp + 16 * s); }
        if (LAT) {
            const int pos = qpos0 + r;
#pragma unroll
            for (int hf = 0; hf < 2; ++hf) {
                const float* ct = WSF(WS_ROPE) + (hf ? 1024 + (pos & 63) * 16 : (pos >> 6) * 16) + 8 * h; const float* st = ct + (hf ? 1024 : 512);
#pragma unroll
                for (int jj = 0; jj < 4; ++jj) { const float c0 = ct[2 * jj], c1 = ct[2 * jj + 1], s0 = st[2 * jj], s1 = st[2 * jj + 1];
                    const unsigned a = qraw[2 * hf][jj], bb = qraw[2 * hf + 1][jj];
                    const float u1l = bflo(a), u1h = bfhi(a), u2l = bflo(bb), u2h = bfhi(bb);
                    qraw[2 * hf][jj] = pk2(u1l * c0 - u2l * s0, u1h * c1 - u2h * s1); qraw[2 * hf + 1][jj] = pk2(u2l * c0 + u1l * s0, u2h * c1 + u1h * s1); }
            }
        }
#pragma unroll
        for (int s = 0; s < 4; ++s) q[t][s] = __builtin_bit_cast(bf16x8, qraw[s]);
    }
    f32x16 O[2][2];
#pragma unroll
    for (int t = 0; t < 2; ++t)
#pragma unroll
        for (int i = 0; i < 16; ++i) { O[t][0][i] = 0.f; O[t][1][i] = 0.f; }
    float mrun[2], lsum[2];
#pragma unroll
    for (int t = 0; t < 2; ++t) { mrun[t] = sink_[layer * 16 + hq0 + 2 * t] * LOG2E; lsum[t] = 1.0f; }
    constexpr float C2 = 0.125f * LOG2E;
    const int nch = LAT ? 7 : 2;
#define ATT_DESC(ci_, kb_, vb_, pitch_, rope_, kpos0_) do { \
        if (LAT) { if ((ci_) < 3) { const int j_ = nb - 1 + (ci_); const size_t row0_ = (size_t)MP + (size_t)b * SEQ_S + (size_t)j_ * 128; \
                kb_ = WSB(WS_Z) + row0_ * INW + OK_ + kvh * 64; vb_ = WSB(WS_Z) + row0_ * INW + OV_ + kvh * 64; pitch_ = INW; rope_ = true; kpos0_ = j_ * 128; } \
            else { const size_t off_ = ((size_t)((b * DEPTH + layer) * 4 + kvh) * 512 + (size_t)((ci_) - 3) * 128) * 64; kb_ = WSB(WS_KC) + off_; vb_ = WSB(WS_VC) + off_; pitch_ = 64; rope_ = false; kpos0_ = 0; } } \
        else { const size_t row0_ = (size_t)b * SEQ_P + (size_t)(ci_) * 128; kb_ = WSB(WS_Z) + row0_ * INW + OK_ + kvh * 64; vb_ = WSB(WS_Z) + row0_ * INW + OV_ + kvh * 64; pitch_ = INW; rope_ = false; kpos0_ = 0; } } while (0)
    const int skey = tid >> 2, spr = tid & 3, sc0 = (spr >> 1) * 32 + (spr & 1) * 8, vkey = (w & 1) * 64 + lane, vc = w >> 1;
    v4u pka, pkb, pv0, pv1;
    LAS float* RT = (LAS float*)(F.lds + 36864);
    if (LAT) { for (int i = tid; i < 768; i += 512) *(LAS f32x4*)(RT + 4 * i) = *(const f32x4*)(WSF(WS_ROPE) + 4 * i); }
#define ATT_LOAD(kb_, vb_, pitch_, rope_, kpos0_) do { \
        const bf16* src_ = (kb_) + (size_t)skey * (pitch_) + sc0; pka = *(const v4u*)src_; pkb = *(const v4u*)(src_ + 16); \
        pv0 = *(const v4u*)((vb_) + (size_t)vkey * (pitch_) + 8 * vc); pv1 = *(const v4u*)((vb_) + (size_t)vkey * (pitch_) + 8 * (vc + 4)); \
        } while (0)
    f32x16 XB;
#pragma unroll
    for (int i = 0; i < 16; ++i) XB[i] = 0.f;
    int ci = (LAT && nb == 0) ? 1 : 0;
    const bf16 *kb, *vb; int pitch; bool rope; int kpos0;
    ATT_DESC(ci, kb, vb, pitch, rope, kpos0);
    ATT_LOAD(kb, vb, pitch, rope, kpos0);
    for (;;) {
        __syncthreads();
        if (rope) {
            const int kpos_ = kpos0 + skey; const LAS float* ct_ = RT + ((spr >> 1) ? 1024 + (kpos_ & 63) * 16 : (kpos_ >> 6) * 16) + 8 * (spr & 1); const LAS float* st_ = ct_ + ((spr >> 1) ? 1024 : 512);
            const f32x4 pct0 = *(const LAS f32x4*)ct_, pct1 = *(const LAS f32x4*)(ct_ + 4), pst0 = *(const LAS f32x4*)st_, pst1 = *(const LAS f32x4*)(st_ + 4);
            const float cc[8] = {pct0[0], pct0[1], pct0[2], pct0[3], pct1[0], pct1[1], pct1[2], pct1[3]}, sn[8] = {pst0[0], pst0[1], pst0[2], pst0[3], pst1[0], pst1[1], pst1[2], pst1[3]};
            v4u o1, o2;
#pragma unroll
            for (int jj = 0; jj < 4; ++jj) { const float c0f = cc[2 * jj], c1f = cc[2 * jj + 1], s0f = sn[2 * jj], s1f = sn[2 * jj + 1];
                const float u1l = bflo(pka[jj]), u1h = bfhi(pka[jj]), u2l = bflo(pkb[jj]), u2h = bfhi(pkb[jj]);
                o1[jj] = pk2(u1l * c0f - u2l * s0f, u1h * c1f - u2h * s1f); o2[jj] = pk2(u2l * c0f + u1l * s0f, u2h * c1f + u1h * s1f); }
            *(LAS v4u*)(Ks + skey * KS_LD + sc0) = o1; *(LAS v4u*)(Ks + skey * KS_LD + sc0 + 16) = o2;
        } else { *(LAS v4u*)(Ks + skey * KS_LD + sc0) = pka; *(LAS v4u*)(Ks + skey * KS_LD + sc0 + 16) = pkb; }
#pragma unroll
        for (int e = 0; e < 4; ++e) { Vt[(8 * vc + 2 * e) * VT_LD + vkey] = (bf16)(pv0[e] & 0xffffu); Vt[(8 * vc + 2 * e + 1) * VT_LD + vkey] = (bf16)(pv0[e] >> 16);
            Vt[(8 * (vc + 4) + 2 * e) * VT_LD + vkey] = (bf16)(pv1[e] & 0xffffu); Vt[(8 * (vc + 4) + 2 * e + 1) * VT_LD + vkey] = (bf16)(pv1[e] >> 16); }
        __syncthreads();
        const bool mask = rope; const int mpos0 = kpos0;
        int nci = ci + 1; if (LAT && nci == 2 && nb == 15) nci = 3;
        const bool has_next = nci < nch;
        if (has_next) { ATT_DESC(nci, kb, vb, pitch, rope, kpos0); ATT_LOAD(kb, vb, pitch, rope, kpos0); }
        const int wj = w & 3;
        const int kt_lo = (LAT && mask && ci == 0) ? wj : 0, kt_hi = (LAT && mask && ci == 2) ? wj + 1 : 4;
#pragma unroll 1
        for (int kt = kt_lo; kt < kt_hi; ++kt) {
            const bool dmask = LAT && mask && ci != 1 && kt == wj;
            if (LAT) { if (dmask) {
#pragma unroll
                for (int i = 0; i < 16; ++i) { const int rel = (mpos0 + 32 * kt + crow(i, h)) - (qpos0 + r); XB[i] = (rel > 128 || rel < -128) ? -1.0e30f : 0.f; } } }
            bf16x8 kf[4];
#pragma unroll
            for (int s = 0; s < 4; ++s) kf[s] = *(const LAS bf16x8*)(Ks + (32 * kt + r) * KS_LD + 16 * s + 8 * h);
            bf16x8 vf[2][2];
#pragma unroll
            for (int s = 0; s < 2; ++s) {
                const LAS bf16* v0p = Vt + r * VT_LD + 32 * kt + 16 * s + 4 * h; const LAS bf16* v1p = v0p + 32 * VT_LD;
                const s16x4 a0 = *(const LAS s16x4*)v0p, a1 = *(const LAS s16x4*)(v0p + 8), b0 = *(const LAS s16x4*)v1p, b1 = *(const LAS s16x4*)(v1p + 8);
                vf[0][s] = __builtin_shufflevector(a0, a1, 0, 1, 2, 3, 4, 5, 6, 7); vf[1][s] = __builtin_shufflevector(b0, b1, 0, 1, 2, 3, 4, 5, 6, 7);
            }
#pragma unroll
            for (int t = 0; t < 2; ++t) {
                f32x16 X;
                if (LAT) X = XB;
                else {
#pragma unroll
                    for (int i = 0; i < 16; ++i) X[i] = 0.f; }
#pragma unroll
                for (int s = 0; s < 4; ++s) X = MFMA32(kf[s], q[t][s], X);
                float p[16]; float mx = -3.0e38f;
#pragma unroll
                for (int i = 0; i < 16; ++i) { float v = X[i];
                    p[i] = v; mx = fmaxf(mx, v); }
                mx = fmaxf(mx, __shfl_xor(mx, 32));
                const float mrun_old = mrun[t]; const float mnew = fmaxf(mrun_old, mx * C2), alpha = __builtin_amdgcn_exp2f(mrun_old - mnew);
                float rs = 0.f;
#pragma unroll
                for (int i = 0; i < 16; ++i) { p[i] = __builtin_amdgcn_exp2f(fmaf(p[i], C2, -mnew)); rs += p[i]; }
                rs += __shfl_xor(rs, 32);
                lsum[t] = lsum[t] * alpha + rs; mrun[t] = mnew;
                if (__builtin_amdgcn_ballot_w64(mnew != mrun_old) != 0ull) {
#pragma unroll
                    for (int i = 0; i < 16; ++i) { O[t][0][i] *= alpha; O[t][1][i] *= alpha; } }
                v4u p0, p1;
#pragma unroll
                for (int jj = 0; jj < 4; ++jj) { p0[jj] = pk2(p[2 * jj], p[2 * jj + 1]); p1[jj] = pk2(p[8 + 2 * jj], p[9 + 2 * jj]); }
                const bf16x8 pf0 = __builtin_bit_cast(bf16x8, p0), pf1 = __builtin_bit_cast(bf16x8, p1);
                O[t][0] = MFMA32(vf[0][0], pf0, O[t][0]); O[t][1] = MFMA32(vf[1][0], pf0, O[t][1]);
                O[t][0] = MFMA32(vf[0][1], pf1, O[t][0]); O[t][1] = MFMA32(vf[1][1], pf1, O[t][1]);
            }
            if (LAT) { if (dmask) {
#pragma unroll
                for (int i = 0; i < 16; ++i) XB[i] = 0.f; } }
        }
        if (!has_next) break;
        ci = nci;
    }
#undef ATT_DESC
#undef ATT_LOAD
#pragma unroll
    for (int t = 0; t < 2; ++t) {
        const float inv = 1.0f / lsum[t];
        bf16* op = WSB(WS_MIXCAT) + (size_t)(tq + r) * DM + (hq0 + 2 * t) * 64 + 4 * h;
#pragma unroll
        for (int gi = 0; gi < 4; ++gi) {
            v2u o; o.x = pk2(O[t][0][4 * gi] * inv, O[t][0][4 * gi + 1] * inv); o.y = pk2(O[t][0][4 * gi + 2] * inv, O[t][0][4 * gi + 3] * inv); *(v2u*)(op + 8 * gi) = o;
            v2u o2; o2.x = pk2(O[t][1][4 * gi] * inv, O[t][1][4 * gi + 1] * inv); o2.y = pk2(O[t][1][4 * gi + 2] * inv, O[t][1][4 * gi + 3] * inv); *(v2u*)(op + 32 + 8 * gi) = o2;
        }
    }
}

template <int HW> __device__ __forceinline__ void pool_g(const Args& A, const LAS bf16* RAW, int S, int s0, int t0, int c) {
    constexpr int W = 2 * HW; float u[32 + W];
#pragma unroll
    for (int jj = 0; jj < 32 + W; ++jj) u[jj] = bf2f(RAW[(8 - HW + jj) * 512 + c]);
    float sum = 0.f;
#pragma unroll
    for (int jj = 0; jj < W; ++jj) sum += u[jj];
    const bool interior = (s0 >= HW) && (s0 + 31 + HW <= S);
    bf16* op = WSB(WS_MIXCAT) + (size_t)t0 * DM + 1024 + c;
#pragma unroll
    for (int o = 0; o < 32; ++o) {
        float rc = 1.0f / (float)W;
        if (!interior) { const int so = s0 + o; const int lo = so - HW > 0 ? so - HW : 0, hi = so + HW < S ? so + HW : S; rc = __builtin_amdgcn_rcpf((float)(hi - lo)); }
        const float pooled = fmaf(sum, rc, -u[o + HW]);
        const unsigned pk = pk2(pooled, 0.f); op[(size_t)o * DM] = (bf16)(pk & 0xffffu);
        if (o < 31) sum += u[o + W] - u[o]; }
}
__device__ __forceinline__ void convpool_tile(Frame& F, const Args& A, int layer, int ti) {
    asm volatile("" : "+s"(ti));
    const int t0 = ti * 32; int seq0, S;
    if (t0 < MP) { seq0 = t0 & ~(SEQ_P - 1); S = SEQ_P; } else { seq0 = MP + ((t0 - MP) & ~(SEQ_S - 1)); S = SEQ_S; }
    PHASE_IDS(); const int s0 = t0 - seq0, c = tid;
    LAS bf16* RAW = (LAS bf16*)F.lds;
    __syncthreads();
    const bool prompt = t0 < MP;
    v4u st[6], pf[16];
#pragma unroll
    for (int k = 0; k < 6; ++k) { const int i = tid + 512 * k, row = i >> 6, ch8 = (i & 63) * 8, s = s0 - 8 + row, sc = s < 0 ? 0 : (s >= S ? S - 1 : s);
        st[k] = *(const v4u*)(WSB(WS_Z) + (size_t)(seq0 + sc) * INW + OPU + ch8); }
    if (prompt) {
#pragma unroll
        for (int k = 0; k < 16; ++k) { const int i = tid + 512 * k, row = (i >> 7) < 62 ? (i >> 7) : 61, ch8 = (i & 127) * 8, s = s0 - 15 + row, sc = s < 0 ? 0 : (s >= S ? S - 1 : s);
            pf[k] = *(const v4u*)(WSB(WS_Z) + (size_t)(seq0 + sc) * INW + OCA + ch8); }
    } else {
#pragma unroll
        for (int k = 0; k < 4; ++k) { const int i = tid + 512 * k, row = i >> 7, ch8 = (i & 127) * 8, s = s0 - 15 + row, sc = s < 0 ? 0 : (s >= S ? S - 1 : s);
            const bf16* pp = WSB(WS_ZP) + (size_t)(seq0 - MP + sc) * 1024 + ch8;
#pragma unroll
            for (int qk = 0; qk < 4; ++qk) pf[4 * k + qk] = *(const v4u*)(pp + (size_t)qk * MS * 1024); }
    }
#pragma unroll
    for (int k = 0; k < 6; ++k) { const int i = tid + 512 * k, row = i >> 6, ch8 = (i & 63) * 8, s = s0 - 8 + row; v4u v = st[k]; if (s < 0 || s >= S) v = (v4u){0u, 0u, 0u, 0u}; *(LAS v4u*)(RAW + row * 512 + ch8) = v; }
    __syncthreads();
    switch (c >> 7) { case 0: pool_g<1>(A, RAW, S, s0, t0, c); break; case 1: pool_g<2>(A, RAW, S, s0, t0, c); break; case 2: pool_g<4>(A, RAW, S, s0, t0, c); break; default: pool_g<8>(A, RAW, S, s0, t0, c); break; }
    __syncthreads();
    if (prompt) {
#pragma unroll
        for (int k = 0; k < 16; ++k) { const int i = tid + 512 * k, row = i >> 7, ch8 = (i & 127) * 8, s = s0 - 15 + row; v4u v = pf[k]; if (s < 0 || s >= S) v = (v4u){0u, 0u, 0u, 0u}; if (row < 62) *(LAS v4u*)(RAW + row * 1024 + ch8) = v; }
    } else {
#pragma unroll 1
        for (int kb = 0; kb < 4; ++kb) {
            if (kb > 0) {
#pragma unroll
                for (int k = 0; k < 4; ++k) { const int i = tid + 512 * (4 * kb + k), row = (i >> 7) < 62 ? (i >> 7) : 61, ch8 = (i & 127) * 8, s = s0 - 15 + row, sc = s < 0 ? 0 : (s >= S ? S - 1 : s);
                    const bf16* pp = WSB(WS_ZP) + (size_t)(seq0 - MP + sc) * 1024 + ch8;
#pragma unroll
                    for (int qk = 0; qk < 4; ++qk) pf[4 * k + qk] = *(const v4u*)(pp + (size_t)qk * MS * 1024); }
            }
#pragma unroll
            for (int k = 0; k < 4; ++k) { const int i = tid + 512 * (4 * kb + k), row = i >> 7, ch8 = (i & 127) * 8, s = s0 - 15 + row;
                float acc8[8];
#pragma unroll
                for (int e = 0; e < 8; ++e) acc8[e] = 0.f;
#pragma unroll
                for (int qk = 0; qk < 4; ++qk)
#pragma unroll
                    for (int e = 0; e < 4; ++e) { acc8[2 * e] += bflo(pf[4 * k + qk][e]); acc8[2 * e + 1] += bfhi(pf[4 * k + qk][e]); }
                v4u v; v.x = pk2(acc8[0], acc8[1]); v.y = pk2(acc8[2], acc8[3]); v.z = pk2(acc8[4], acc8[5]); v.w = pk2(acc8[6], acc8[7]);
                if (s < 0 || s >= S) v = (v4u){0u, 0u, 0u, 0u};
                if (row < 62) *(LAS v4u*)(RAW + row * 1024 + ch8) = v; }
        }
    }
    float wt[31], hv[62];
#pragma unroll
    for (int j = 0; j < 31; ++j) wt[j] = conv_dw_[((size_t)layer * 31 + j) * 512 + c];
    const float cb = conv_b_[layer * 512 + c];
    __syncthreads();
#pragma unroll
    for (int jj = 0; jj < 62; ++jj) { const float a = bf2f(RAW[jj * 1024 + c]), g = bf2f(RAW[jj * 1024 + 512 + c]); hv[jj] = a * __builtin_amdgcn_rcpf(1.f + __expf(-g)); }
    float acc[32];
#pragma unroll
    for (int o = 0; o < 32; ++o) { float a = cb;
#pragma unroll
        for (int j = 0; j < 31; ++j) a = fmaf(hv[o + j], wt[j], a);
        acc[o] = a; }
    LAS float* CT = (LAS float*)F.lds;
    __syncthreads();
#pragma unroll
    for (int o = 0; o < 32; ++o) CT[o * 512 + c] = acc[o];
    __syncthreads();
    f32x4 lg0 = *(const f32x4*)(conv_ln_g_ + layer * 512 + 8 * lane), lg1 = *(const f32x4*)(conv_ln_g_ + layer * 512 + 8 * lane + 4);
    f32x4 lb0 = *(const f32x4*)(conv_ln_b_ + layer * 512 + 8 * lane), lb1 = *(const f32x4*)(conv_ln_b_ + layer * 512 + 8 * lane + 4);
#pragma unroll 1
    for (int qq = 0; qq < 4; ++qq) {
        const int o = 4 * wv + qq;
        f32x4 v0 = *(const LAS f32x4*)(CT + o * 512 + 8 * lane), v1 = *(const LAS f32x4*)(CT + o * 512 + 8 * lane + 4);
        const float mu = wave_sum((v0[0] + v0[1]) + (v0[2] + v0[3]) + (v1[0] + v1[1]) + (v1[2] + v1[3])) * (1.0f / 512.0f);
        v0 = v0 - mu; v1 = v1 - mu;
        const float var = wave_sum((v0[0] * v0[0] + v0[1] * v0[1]) + (v0[2] * v0[2] + v0[3] * v0[3]) + (v1[0] * v1[0] + v1[1] * v1[1]) + (v1[2] * v1[2] + v1[3] * v1[3])) * (1.0f / 512.0f);
        const float rstd = __builtin_amdgcn_rsqf(var + EPS);
        f32x4 y0 = v0 * rstd * lg0 + lb0, y1 = v1 * rstd * lg1 + lb1;
#pragma unroll
        for (int e = 0; e < 4; ++e) { y0[e] = y0[e] * __builtin_amdgcn_rcpf(1.f + __expf(-y0[e])); y1[e] = y1[e] * __builtin_amdgcn_rcpf(1.f + __expf(-y1[e])); }
        v4u ov; ov.x = pk2(y0[0], y0[1]); ov.y = pk2(y0[2], y0[3]); ov.z = pk2(y1[0], y1[1]); ov.w = pk2(y1[2], y1[3]);
        *(v4u*)(WSB(WS_MIXCAT) + (size_t)(t0 + o) * DM + 1536 + 8 * lane) = ov;
    }
}

__global__ void __launch_bounds__(NWAVES * 64, 2) fwd_kernel(Args args) {
    extern __shared__ __attribute__((aligned(16))) unsigned char lds[];
    Frame F;
    F.lds = (LAS unsigned char*)lds;
    F.G = gridDim.x; F.bx = blockIdx.x;
    const Args& A = args;
    unsigned char* ws = args.ws;
    volatile LAS unsigned* MISC = (volatile LAS unsigned*)(F.lds + MISC_OFF);
    if (threadIdx.x < 32) MISC[threadIdx.x] = 0u;
    __syncthreads();
    XcdBarrier bar = xcd_barrier_post((unsigned*)(ws + WS_CTL) + CW_BAR, MISC + 8);

    for (int rep = 0; rep < DUPN(0); ++rep) { if (PH(0)) p0a(F, A);
    xcd_barrier(bar); }
    for (int rp_ = 0; rp_ < DUPN(1); ++rp_) {
        const int fl = F.bx >> 5, fu = F.bx & 31;
        pg8::OneUnit S; S.has = F.bx < 128; S.pm = fu >> 2; S.pn = fu & 3;
        S.kt0 = (S.pn == 0) ? 0 : (S.pn == 1 ? 4 : 8); S.nt = (S.pn < 2) ? 4 : 8;
        const int fls = S.has ? fl : 0;
        pg8::Gemm g{WSB(WS_WOT2) + (size_t)fls * DM * 1024, WSB(WS_WBD) + (size_t)fls * 1024 * 1024, DM, 1024, 1024};
        pg8::EpiB<0, false> E{WSB(WS_WOUT) + (size_t)fls * DM * DM + 1024, DM, nullptr, nullptr, 0, nullptr, 0, 0, 0};
        if (PH(1)) pg8::gemm_phase<pg8::EpiB<0, false>, pg8::OneUnit, false, true>(F.lds, g, S, E);
        __syncthreads();
        const int gt = F.bx * (NWAVES * 64) + (int)threadIdx.x, NGT = F.G * NWAVES * 64;
        if (PH(2)) thin_phase<0, false>(F, A, nullptr, 0, 0, g_pre1_, DM, 0, 0, true);
    }
    xcd_barrier(bar);

    for (int l = 0; l < DEPTH; ++l) {
        for (int rep = 0; rep < DUPN(3); ++rep) {
            pg8::Gemm g{WSB(WS_H), WSB(WS_WIN) + (size_t)l * INW * DM, M, INW, DM}; pg8::P1Order S; S.c = F.bx; S.nt = DM / 64;
            pg8::EpiB<0, true> E{WSB(WS_Z), INW, A.out + OUT_NK, A.out + OUT_NV, l, WSB(WS_ZP), 1024, (size_t)MS * 1024, 2048};
            if (PH(3)) pg8::gemm_phase<pg8::EpiB<0, true>, pg8::P1Order, true, true>(F.lds, g, S, E);
        xcd_barrier(bar);
        }
        for (int rep = 0; rep < DUPN(4); ++rep) {
            if (F.bx < 128) { if (PH(4)) { attn_unit<true>(F, A, l, F.bx); __syncthreads(); } if (PH(6)) { convpool_tile(F, A, l, F.bx); __syncthreads(); } }
            else { if (PH(5)) { attn_unit<false>(F, A, l, 2 * (F.bx - 128)); __syncthreads(); attn_unit<false>(F, A, l, 2 * (F.bx - 128) + 1); __syncthreads(); }
                   if (PH(6)) { convpool_tile(F, A, l, F.bx); __syncthreads(); convpool_tile(F, A, l, 128 + F.bx); __syncthreads(); } }
        xcd_barrier(bar);
        }
        for (int rep = 0; rep < DUPN(7); ++rep) {
            pg8::Gemm g{WSB(WS_MIXCAT), WSB(WS_WOUT) + (size_t)l * DM * DM, M, DM, DM}; pg8::SplitOrder S; S.c = F.bx; S.nt = DM / 64;
            pg8::EpiB<0, false> E{WSB(WS_MIX), DM, nullptr, nullptr, 0, WSB(WS_MIX2), DM, 0, 0};
            if (PH(7)) pg8::gemm_phase<pg8::EpiB<0, false>, pg8::SplitOrder, true, true>(F.lds, g, S, E);
            if (rep + 1 < DUPN(7)) xcd_barrier(bar);
        }
        thin_phase<1, false, 4>(F, A, g_post1_ + l * DM, 2 * DM, l, g_pre2_ + l * DM, 4 * DM, 3 * DM, l, l == 0, &bar);
        xcd_barrier(bar);
        for (int rep = 0; rep < DUPN(9); ++rep) {
            pg8::Gemm g{WSB(WS_H), WSB(WS_W1) + (size_t)l * DFF * DM, M, DFF, DM}; pg8::StaticOrder S; S.init(M, DFF, DM, F.G, F.bx);
            pg8::EpiB<1, false> E{WSB(WS_U), DFF, nullptr, nullptr, 0, nullptr, 0, 0, 0};
            if (PH(9)) pg8::gemm_phase<pg8::EpiB<1, false>, pg8::StaticOrder, true, true>(F.lds, g, S, E);
        xcd_barrier(bar);
        }
        for (int rep = 0; rep < DUPN(10); ++rep) {
            pg8::Gemm g{WSB(WS_U), WSB(WS_W2) + (size_t)l * DM * DFF, M, DM, DFF}; pg8::SplitOrder S; S.c = F.bx; S.nt = DFF / 64;
            pg8::EpiB<0, false> E{WSB(WS_MIX), DM, nullptr, nullptr, 0, WSB(WS_MIX2), DM, 0, 0};
            if (PH(10)) pg8::gemm_phase<pg8::EpiB<0, false>, pg8::SplitOrder, true, true>(F.lds, g, S, E);
            if (rep + 1 < DUPN(10)) xcd_barrier(bar);
        }
        if (l + 1 < DEPTH) { thin_phase<1, false, 4>(F, A, g_post2_ + l * DM, 5 * DM, l, g_pre1_ + (l + 1) * DM, DM, 0, l + 1, false, &bar); xcd_barrier(bar); }
        else thin_phase<2, false, 4>(F, A, g_post2_ + l * DM, 5 * DM, l, nullptr, 0, 0, l, false, &bar);
    }
}

extern "C" void kernel_launch(void* const* d_in, const int* in_sizes, int n_in, void* d_out, int out_size, void* d_ws, size_t ws_size, hipStream_t stream) {
    static int grid = 0;
    if (grid == 0) {
        if (n_in != 24 || ws_size < WS_END) { fprintf(stderr, "kernel_launch: bad arguments (n_in %d, ws %zu)\n", n_in, ws_size); grid = -1; return; }
        int dev = 0, cus = 0, per_cu = 0;
        if (hipGetDevice(&dev) != hipSuccess || hipDeviceGetAttribute(&cus, hipDeviceAttributeMultiprocessorCount, dev) != hipSuccess) { grid = -1; return; }
        if (hipFuncSetAttribute((const void*)fwd_kernel, hipFuncAttributeMaxDynamicSharedMemorySize, LDS_BYTES) != hipSuccess) { fprintf(stderr, "kernel_launch: hipFuncSetAttribute failed\n"); grid = -1; return; }
        if (hipOccupancyMaxActiveBlocksPerMultiprocessor(&per_cu, (const void*)fwd_kernel, NWAVES * 64, LDS_BYTES) != hipSuccess || per_cu < 1) { fprintf(stderr, "kernel_launch: occupancy query says %d\n", per_cu); per_cu = 1; }
        (void)hipGetLastError();
        if (cus < 256) { fprintf(stderr, "kernel_launch: needs 256 CUs, found %d\n", cus); grid = -1; return; }
        grid = 256;
    }
    if (grid < 0) return;
    (void)in_sizes; (void)out_size;
    if (hipMemsetAsync((char*)d_ws + WS_CTL, 0, CTL_ZERO_BYTES, stream) != hipSuccess) return;
    Args a{};
    for (int i = 0; i < 24; ++i) a.in[i] = (const float*)d_in[i];
    a.out = (float*)d_out; a.ws = (unsigned char*)d_ws;
    hipLaunchKernelGGL(fwd_kernel, dim3(grid), dim3(NWAVES * 64), LDS_BYTES, stream, a);
}
```

```cpp
#include <hip/hip_runtime.h>
#include <cstdio>
#include <cstdint>

namespace pg8 {
#define PG8_LAS __attribute__((address_space(3)))
typedef unsigned short bf16_t;
typedef short bf16x8 __attribute__((ext_vector_type(8)));
typedef float f32x4 __attribute__((ext_vector_type(4)));
typedef unsigned u32x4 __attribute__((ext_vector_type(4)));
constexpr int BM = 256, BK = 64, HALF = 128, HTB = HALF * BK * 2  , STAGE_BYTES = 8 * HTB, NXCD = 8, WGM = 8;

__host__ __device__ __forceinline__ int lds_byte(int r, int c) { const int st = (r >> 4) * 2 + (c >> 5), rr = r & 15, cc = c & 31, ob = rr * 64 + cc * 2; return st * 1024 + (ob ^ (((ob >> 9) & 1) << 5)); }
__host__ __device__ __forceinline__ void stage_rc(int b, int& R, int& C) { const int st = b / 1024, sb = b % 1024, swz = sb ^ (((sb >> 9) & 1) << 5); R = (st >> 1) * 16 + swz / 64; C = (st & 1) * 32 + (swz % 64) / 2; }
__host__ __device__ __forceinline__ int perm32(int rho) { const int n = rho >> 4, i = rho & 15; return 8 * (i >> 2) + 4 * n + (i & 3); }

struct Unit { int pm, pn, kt0, ktn, part; };
struct Gemm { const bf16_t* A; const bf16_t* Bt; int M, N, K; };

struct StaticOrder {
    int nM, nN, nwg, G, c, nt;
    __host__ __device__ void init(int M, int N, int K, int G_, int c_) { nM = M / BM; nN = N / BM; nwg = nM * nN; G = G_; c = c_; nt = K / BK; }
    __host__ __device__ bool next(int i, Unit& u) const {
        const long L = (long)i * G + c; if (L >= nwg) return false;
        int wgid = (int)L; { const int q = nwg / NXCD, r = nwg % NXCD, xcd = wgid % NXCD, off = wgid / NXCD; wgid = (xcd < r ? xcd * (q + 1) : r * (q + 1) + (xcd - r) * q) + off; }
        const int nig = WGM * nN, gid = wgid / nig, fm = gid * WGM, gsz = (nM - fm) < WGM ? (nM - fm) : WGM;
        u.pm = fm + ((wgid % nig) % gsz); u.pn = (wgid % nig) / gsz; u.kt0 = 0; u.ktn = nt; u.part = 0; return true;
    }
    __device__ __forceinline__ void a_ready(const Unit&) const {}
    __device__ __forceinline__ void done(const Unit&) const {}
};
struct OneUnit {
    int pm, pn, kt0, nt; bool has;
    __device__ bool next(int i, Unit& u) const { if (i != 0 || !has) return false; u.pm = pm; u.pn = pn; u.kt0 = kt0; u.ktn = nt; u.part = 0; return true; }
    __device__ __forceinline__ void a_ready(const Unit&) const {}
    __device__ __forceinline__ void done(const Unit&) const {}
};

struct SplitOrder {
    int c, nt;
    __device__ bool next(int i, Unit& u) const {
        if (i > 1) return false;
        const int w = (c & 7) * 32 + (c >> 3);
        if (i == 0) { u.pm = w >> 3; u.pn = w & 7; u.kt0 = 0; u.ktn = nt; u.part = 0; }
        else { const int kh = w >> 7, t = w & 127; u.pm = 32 + (t >> 3); u.pn = t & 7; u.kt0 = kh * (nt >> 1); u.ktn = nt >> 1; u.part = kh; }
        return true;
    }
    __device__ __forceinline__ void a_ready(const Unit&) const {}
    __device__ __forceinline__ void done(const Unit&) const {}
};
struct P1Order {
    int c, nt;
    __device__ bool next(int i, Unit& u) const {
        if (i > 2) return false;
        if (i < 2) { const int L = i * 256 + c; const int wgid = (L & 7) * 64 + (L >> 3);
            if (wgid < 384) { const int gid = wgid / 96, rr = wgid % 96; u.pm = 8 * gid + (rr & 7); u.pn = rr >> 3; }
            else { const int w2 = wgid - 384, gid = w2 >> 6, rr = w2 & 63; u.pm = 32 + 8 * gid + (rr & 7); u.pn = rr >> 3; }
            u.kt0 = 0; u.ktn = nt; u.part = 0; }
        else { const int x = c & 7, j = c >> 3, kq = x & 3;
            u.pm = 32 + 8 * (x >> 2) + (j & 7); u.pn = 8 + (j >> 3); u.kt0 = kq * (nt >> 2); u.ktn = nt >> 2; u.part = 1 + kq; }
        return true;
    }
    __device__ __forceinline__ void a_ready(const Unit&) const {}
    __device__ __forceinline__ void done(const Unit&) const {}
};
typedef float f32x2_t __attribute__((ext_vector_type(2))); typedef __bf16 bf16x2_t __attribute__((ext_vector_type(2)));
__device__ __forceinline__ unsigned cvt_pk_bf16(float lo, float hi) { f32x2_t v = {lo, hi}; bf16x2_t b = __builtin_convertvector(v, bf16x2_t); return __builtin_bit_cast(unsigned, b); }

struct EpiF32 {
    static constexpr bool PERM = false, AFTER_DRAIN = false;
    float* C; float* C1; int ldc;
    __device__ __forceinline__ void operator()(const f32x4 (&acc)[2][2][4][2], const Unit& u, int wr, int wc, int fr, int fq) const {
        const int row0 = (u.part ? (u.pm - 32) : u.pm) * BM + wr * 64 + fr, col0 = u.pn * BM + wc * 32 + 4 * fq;
        float* base = u.part ? C1 : C;
#pragma unroll
        for (int ai = 0; ai < 2; ++ai)
#pragma unroll
            for (int m = 0; m < 4; ++m) { float* rowp = base + (size_t)(row0 + ai * HALF + m * 16) * ldc + col0;
#pragma unroll
                for (int bj = 0; bj < 2; ++bj)
#pragma unroll
                    for (int n = 0; n < 2; ++n) *(f32x4*)(rowp + bj * HALF + n * 16) = acc[ai][bj][m][n]; }
    }
};
template <int ACT, bool KV> struct EpiB {
    static constexpr bool PERM = true, AFTER_DRAIN = false;
    bf16_t* O; int ldc; float* nk; float* nv; int layer;
    bf16_t* O1; int ldc1; size_t pstride; int pcol0; bf16_t* Qc; int qm;
    __device__ __forceinline__ void operator()(const f32x4 (&acc)[2][2][4][2], const Unit& u, int wr, int wc, int fr, int fq) const {
        const int rloc = wr * 64 + fr, row0 = (u.part ? (u.pm - 32) : u.pm) * BM + rloc, cloc = wc * 32 + 8 * fq, col0 = u.pn * BM + cloc - (u.part ? pcol0 : 0);
        bf16_t* base = u.part ? O1 + (size_t)(u.part - 1) * pstride : O; const int ld = u.part ? ldc1 : ldc;
        float* kvp = nullptr;
        const bool cq = KV && u.part == 0 && u.pn < 6;
        if (KV) { if (u.pm < 32 && (u.pn == 4 || u.pn == 5)) kvp = (u.pn == 4 ? nk : nv) + ((size_t)(u.pm * 4 + layer) * 256 + rloc) * 256 + cloc; }
#pragma unroll
        for (int ai = 0; ai < 2; ++ai)
#pragma unroll
            for (int m = 0; m < 4; ++m) { bf16_t* rowp = base + (size_t)(row0 + ai * HALF + m * 16) * ld + col0;
#pragma unroll
                for (int bj = 0; bj < 2; ++bj) { f32x4 v0 = acc[ai][bj][m][0], v1 = acc[ai][bj][m][1];
                    if (ACT == 1) {
#pragma unroll
                        for (int j = 0; j < 4; ++j) { const float a = fmaxf(v0[j], 0.f), b = fmaxf(v1[j], 0.f); v0[j] = a * a; v1[j] = b * b; } }
                    u32x4 w; w.x = cvt_pk_bf16(v0[0], v0[1]); w.y = cvt_pk_bf16(v0[2], v0[3]); w.z = cvt_pk_bf16(v1[0], v1[1]); w.w = cvt_pk_bf16(v1[2], v1[3]);
                    if (KV && cq) { const int c = u.pn * BM + cloc + bj * HALF; *(u32x4*)(Qc + ((size_t)(c >> 6) * qm + (row0 + ai * HALF + m * 16)) * 64 + (c & 63)) = w; }
                    else *(u32x4*)(rowp + bj * HALF) = w;
                    if (KV) { if (kvp) { float* p = kvp + (size_t)(ai * HALF + m * 16) * 256 + bj * HALF; *(f32x4*)p = v0; *(f32x4*)(p + 4) = v1; } }
                } }
    }
};

template <class Epi, class Sched, bool ALIGN_EPI = false, bool SP2 = false>
__device__ __forceinline__ void gemm_phase(PG8_LAS unsigned char* lds, const Gemm g, const Sched& S, const Epi& E) {
    int tid_ = threadIdx.x; asm volatile("" : "+v"(tid_));
    const int tid = tid_, wid = __builtin_amdgcn_readfirstlane(tid >> 6), lane = tid & 63, wr = wid >> 2, wc = wid & 3, fr = lane & 15, fq = lane >> 4;
    const int K = g.K;
    unsigned voffA[2], voffB[2];
#pragma unroll
    for (int i = 0; i < 2; ++i) { int R, C; stage_rc(tid * 16 + i * 8192, R, C); const int Rb = Epi::PERM ? ((R & ~31) + perm32(R & 31)) : R;
        voffA[i] = (unsigned)(R * K + C) * 2u; voffB[i] = (unsigned)(Rb * K + C) * 2u; }
    const size_t kstep = (size_t)(BK * 2);
    const size_t hstep = (size_t)HALF * K * 2;
    const size_t tstep = 2 * hstep;
    const unsigned ldsw = (unsigned)wid * 1024u;
    const int aoff = lds_byte(wr * 64 + fr, fq * 8), boff = lds_byte(wc * 32 + fr, fq * 8);
#define PG8_SA(b, h) (((b) * 2 + (h)) * HTB)
#define PG8_SB(b, h) ((4 + (b) * 2 + (h)) * HTB)
#define PG8_STAGE(bufoff, gbase, voff) do { _Pragma("unroll") for (int _i = 0; _i < 2; ++_i) \
        __builtin_amdgcn_global_load_lds((const unsigned*)((const char*)(gbase) + (voff)[_i]), (PG8_LAS unsigned*)(lds + (bufoff) + ldsw + _i * 8192), 16, 0, 0); } while (0)
#define PG8_LDA(dst, b, h) do { _Pragma("unroll") for (int m = 0; m < 4; ++m) _Pragma("unroll") for (int k = 0; k < 2; ++k) dst[m][k] = *(const PG8_LAS bf16x8*)(lds + PG8_SA(b, h) + aoff + m * 2048 + k * 1024); } while (0)
#define PG8_LDB(dst, b, h) do { _Pragma("unroll") for (int n = 0; n < 2; ++n) _Pragma("unroll") for (int k = 0; k < 2; ++k) dst[n][k] = *(const PG8_LAS bf16x8*)(lds + PG8_SB(b, h) + boff + n * 2048 + k * 1024); } while (0)
#define PG8_MMA(ai, bj, At, Bt) do { __builtin_amdgcn_s_setprio(1); _Pragma("unroll") for (int m = 0; m < 4; ++m) _Pragma("unroll") for (int n = 0; n < 2; ++n) _Pragma("unroll") for (int k = 0; k < 2; ++k) \
        acc[ai][bj][m][n] = __builtin_amdgcn_mfma_f32_16x16x32_bf16(Bt[n][k], At[m][k], acc[ai][bj][m][n], 0, 0, 0); __builtin_amdgcn_s_setprio(0); } while (0)
#define PG8_WAIT_V(n) asm volatile("s_waitcnt vmcnt(" #n ")" ::: "memory")
#define PG8_WAIT_L(n) asm volatile("s_waitcnt lgkmcnt(" #n ")" ::: "memory")
#define PG8_BAR __builtin_amdgcn_s_barrier()
#define PG8_SCHED __builtin_amdgcn_sched_barrier(0)
    Unit cur, nxt; int ui = 0;
    if (!S.next(0, cur)) return;
    f32x4 acc[2][2][4][2];
#pragma unroll
    for (int a = 0; a < 2; ++a)
#pragma unroll
        for (int b = 0; b < 2; ++b)
#pragma unroll
            for (int m = 0; m < 4; ++m)
#pragma unroll
                for (int n = 0; n < 2; ++n) acc[a][b][m][n] = (f32x4){0.f, 0.f, 0.f, 0.f};
    bf16x8 At[4][2], B0[2][2], B1[2][2];
    const char* cA = (const char*)g.A + (size_t)cur.pm * tstep + (size_t)cur.kt0 * kstep; const char* cB = (const char*)g.Bt + (size_t)cur.pn * tstep + (size_t)cur.kt0 * kstep;
    S.a_ready(cur);
    if constexpr (SP2) {
        PG8_STAGE(PG8_SB(0, 0), cB, voffB); PG8_STAGE(PG8_SB(0, 1), cB + hstep, voffB); PG8_STAGE(PG8_SA(0, 0), cA, voffA); PG8_STAGE(PG8_SA(0, 1), cA + hstep, voffA);
        if (wr == 1) PG8_BAR;
        PG8_WAIT_V(2); PG8_BAR;
        PG8_STAGE(PG8_SB(1, 0), cB + kstep, voffB); PG8_STAGE(PG8_SA(1, 0), cA + kstep, voffA); PG8_STAGE(PG8_SB(1, 1), cB + hstep + kstep, voffB);
        PG8_WAIT_V(6); PG8_BAR;
    } else {
        PG8_STAGE(PG8_SB(0, 0), cB, voffB); PG8_STAGE(PG8_SA(0, 0), cA, voffA); PG8_STAGE(PG8_SB(0, 1), cB + hstep, voffB); PG8_STAGE(PG8_SA(0, 1), cA + hstep, voffA);
        if (wr == 1) PG8_BAR;
        PG8_WAIT_V(4); PG8_BAR;
        PG8_STAGE(PG8_SB(1, 0), cB + kstep, voffB); PG8_STAGE(PG8_SA(1, 0), cA + kstep, voffA); PG8_STAGE(PG8_SB(1, 1), cB + hstep + kstep, voffB);
        PG8_WAIT_V(6); PG8_BAR;
    }
    for (;;) {
        const bool has_next = S.next(ui + 1, nxt);
        const char* nA = has_next ? (const char*)g.A + (size_t)nxt.pm * tstep + (size_t)nxt.kt0 * kstep : cA; const char* nB = has_next ? (const char*)g.Bt + (size_t)nxt.pn * tstep + (size_t)nxt.kt0 * kstep : cB;
        const int nt = cur.ktn;
        for (int t = 0; t < nt; t += 2) {
            const bool last = (t == nt - 2);
            const char* a1 = cA + (size_t)(t + 1) * kstep;
            const char* a2 = last ? nA : cA + (size_t)(t + 2) * kstep; const char* b2 = last ? nB : cB + (size_t)(t + 2) * kstep;
            const char* a3 = a2 + kstep; const char* b3 = b2 + kstep;
            if (last && has_next) S.a_ready(nxt);
            if constexpr (SP2) {
            PG8_LDB(B0, 0, 0); PG8_LDB(B1, 0, 1); PG8_SCHED; PG8_LDA(At, 0, 0); PG8_STAGE(PG8_SA(1, 1), a1 + hstep, voffA);
            PG8_WAIT_V(8); PG8_WAIT_L(0); PG8_BAR; PG8_MMA(0, 0, At, B0); PG8_MMA(0, 1, At, B1); PG8_BAR; PG8_SCHED;
            PG8_LDA(At, 0, 1); PG8_STAGE(PG8_SB(0, 0), b2, voffB); PG8_STAGE(PG8_SB(0, 1), b2 + hstep, voffB); PG8_STAGE(PG8_SA(0, 0), a2, voffA);
            PG8_WAIT_V(8); PG8_WAIT_L(0); PG8_BAR; PG8_MMA(1, 0, At, B0); PG8_MMA(1, 1, At, B1); PG8_BAR; PG8_SCHED;
            PG8_LDB(B0, 1, 0); PG8_LDB(B1, 1, 1); PG8_SCHED; PG8_LDA(At, 1, 0); PG8_STAGE(PG8_SA(0, 1), a2 + hstep, voffA);
            PG8_WAIT_V(8); PG8_WAIT_L(0); PG8_BAR; PG8_MMA(0, 0, At, B0); PG8_MMA(0, 1, At, B1); PG8_BAR; PG8_SCHED;
            PG8_LDA(At, 1, 1); PG8_STAGE(PG8_SB(1, 0), b3, voffB); PG8_STAGE(PG8_SB(1, 1), b3 + hstep, voffB); PG8_STAGE(PG8_SA(1, 0), a3, voffA);
            PG8_WAIT_V(8); PG8_WAIT_L(0); PG8_BAR; PG8_MMA(1, 0, At, B0); PG8_MMA(1, 1, At, B1); PG8_BAR; PG8_SCHED;
            } else {
            PG8_LDB(B0, 0, 0); PG8_SCHED; PG8_LDA(At, 0, 0); PG8_STAGE(PG8_SA(1, 1), a1 + hstep, voffA);
            PG8_WAIT_L(8); PG8_BAR; PG8_WAIT_L(0); PG8_MMA(0, 0, At, B0); PG8_BAR; PG8_SCHED;
            PG8_LDB(B1, 0, 1); PG8_STAGE(PG8_SB(0, 0), b2, voffB);
            PG8_BAR; PG8_WAIT_L(0); PG8_MMA(0, 1, At, B1); PG8_BAR;
            PG8_LDA(At, 0, 1); PG8_STAGE(PG8_SA(0, 0), a2, voffA);
            PG8_BAR; PG8_WAIT_L(0); PG8_MMA(1, 0, At, B0); PG8_BAR; PG8_SCHED;
            PG8_STAGE(PG8_SB(0, 1), b2 + hstep, voffB);
            PG8_WAIT_V(6); PG8_BAR; PG8_MMA(1, 1, At, B1); PG8_BAR;
            PG8_LDB(B0, 1, 0); PG8_SCHED; PG8_LDA(At, 1, 0); PG8_STAGE(PG8_SA(0, 1), a2 + hstep, voffA);
            PG8_WAIT_L(8); PG8_BAR; PG8_WAIT_L(0); PG8_MMA(0, 0, At, B0); PG8_BAR; PG8_SCHED;
            PG8_LDB(B1, 1, 1); PG8_STAGE(PG8_SB(1, 0), b3, voffB);
            PG8_BAR; PG8_WAIT_L(0); PG8_MMA(0, 1, At, B1); PG8_BAR;
            PG8_LDA(At, 1, 1); PG8_STAGE(PG8_SA(1, 0), a3, voffA);
            PG8_BAR; PG8_WAIT_L(0); PG8_MMA(1, 0, At, B0); PG8_BAR; PG8_SCHED;
            PG8_STAGE(PG8_SB(1, 1), b3 + hstep, voffB);
            PG8_WAIT_V(6); PG8_BAR; PG8_MMA(1, 1, At, B1); PG8_BAR;
            }
        }
        if constexpr (ALIGN_EPI) { if (wr == 0) PG8_BAR; }
        if constexpr (!Epi::AFTER_DRAIN) { E(acc, cur, wr, wc, fr, fq); S.done(cur); }
        if (!has_next) break;
#pragma unroll
        for (int a = 0; a < 2; ++a)
#pragma unroll
            for (int b = 0; b < 2; ++b)
#pragma unroll
                for (int m = 0; m < 4; ++m)
#pragma unroll
                    for (int n = 0; n < 2; ++n) acc[a][b][m][n] = (f32x4){0.f, 0.f, 0.f, 0.f};
        cur = nxt; cA = nA; cB = nB; ++ui;
        if constexpr (ALIGN_EPI) { if (wr == 1) PG8_BAR; }
    }
    PG8_WAIT_V(0);
    if constexpr (!ALIGN_EPI) { if (wr == 0) PG8_BAR; }
    PG8_BAR;
#undef PG8_SA
#undef PG8_SB
#undef PG8_STAGE
#undef PG8_LDA
#undef PG8_LDB
#undef PG8_MMA
#undef PG8_WAIT_V
#undef PG8_WAIT_L
#undef PG8_BAR
#undef PG8_SCHED
}
}

#ifndef PHASE_MASK
#define PHASE_MASK 0xFFFF
#endif
#define PH(k) ((PHASE_MASK >> (k)) & 1)
#ifndef DUP_MASK
#define DUP_MASK 0
#endif
#define DUPN(k) (1 + ((DUP_MASK >> (k)) & 1))
constexpr int NWAVES = 8;
constexpr int DM = 2048, NB_P = 32, SEQ_P = 256, DEPTH = 4, NB_S = 2, SEQ_S = 2048, PAST = 512;
constexpr int MP = NB_P * SEQ_P, MS = NB_S * SEQ_S, M = MP + MS;
constexpr int INW = 3072, DFF = 8192, HD = 64;
constexpr int OK_ = 1024, OV_ = 1280, OPU = 1536, OCA = 2048, OCG = 2560;
constexpr int ADA = 6 * DM;
constexpr float EPS = 1e-6f;
constexpr float LOG2E = 1.4426950408889634f;
constexpr size_t OUT_Y = 0, OUT_NK = (size_t)M * DM, OUT_NV = OUT_NK + (size_t)NB_P * DEPTH * SEQ_P * 256;

constexpr size_t MiB = 1u << 20;
constexpr size_t WS_CTL = 0, CTL_ZERO_BYTES = 1 * MiB;
constexpr size_t WS_MODS = 1 * MiB;
constexpr size_t WS_ROPE = 2 * MiB;
constexpr size_t WS_MODP = 3 * MiB;
constexpr size_t WS_KC = 8 * MiB;
constexpr size_t WS_VC = 10 * MiB;
constexpr size_t WS_WBD = 12 * MiB;
constexpr size_t WS_WOT2 = 20 * MiB;
constexpr size_t WS_WIN = 36 * MiB;
constexpr size_t WS_WOUT = 84 * MiB;
constexpr size_t WS_W1 = 116 * MiB;
constexpr size_t WS_W2 = 244 * MiB;
constexpr size_t WS_H = 372 * MiB;
constexpr size_t WS_Z = 420 * MiB;
constexpr size_t WS_MIXCAT = 492 * MiB;
constexpr size_t WS_MIX = 540 * MiB;
constexpr size_t WS_QKV = 588 * MiB;
constexpr size_t WS_U = 636 * MiB;
constexpr size_t WS_MIX2 = 828 * MiB;
constexpr size_t WS_ZP = 844 * MiB;
constexpr size_t WS_XB = 876 * MiB;
constexpr size_t WS_END = 924 * MiB;
constexpr int CW_BAR = 4096, CW_GEMV = 1024;

constexpr int LDS_BYTES = 147456;
constexpr int MISC_OFF = 135168;

#define GAS __attribute__((address_space(1)))
#define LAS __attribute__((address_space(3)))
typedef unsigned short bf16;
typedef unsigned v4u __attribute__((ext_vector_type(4)));
typedef unsigned v2u __attribute__((ext_vector_type(2)));
typedef float f32x4 __attribute__((ext_vector_type(4)));
typedef float f32x16 __attribute__((ext_vector_type(16)));
typedef short bf16x8 __attribute__((ext_vector_type(8)));
typedef short s16x4 __attribute__((ext_vector_type(4)));
#define LDS_WAIT() asm volatile("s_waitcnt lgkmcnt(0)" ::: "memory")
#define VM_WAIT() asm volatile("s_waitcnt vmcnt(0)" ::: "memory")
__device__ __forceinline__ unsigned pk2(float lo, float hi) { return pg8::cvt_pk_bf16(lo, hi); }
__device__ __forceinline__ float bf2f(bf16 b) { return __uint_as_float((unsigned)b << 16); }
__device__ __forceinline__ float bflo(unsigned w) { return __uint_as_float(w << 16); }
__device__ __forceinline__ float bfhi(unsigned w) { return __uint_as_float(w & 0xffff0000u); }

#define XB_TMO      128
#define XB_XCNT(j)  (256  + 64 * (j))
#define XB_XSUB(j)  (1280 + 64 * (j))
#define XB_XGEN(j)  (2304 + 64 * (j))
#define XB_TOP      3328
#define XB_TOPGEN   3392
#define XCD_BAR_WORDS 3456
#define XB_SPIN_CAP (1u << 18)
__device__ __forceinline__ unsigned xb_ld(unsigned* p)              { return __hip_atomic_load(p, __ATOMIC_RELAXED, __HIP_MEMORY_SCOPE_AGENT); }
__device__ __forceinline__ unsigned xb_add(unsigned* p, unsigned v) { return __hip_atomic_fetch_add(p, v, __ATOMIC_RELAXED, __HIP_MEMORY_SCOPE_AGENT); }
__device__ __forceinline__ unsigned xb_xcc_id() { return (unsigned)__builtin_amdgcn_s_getreg((3 << 11) | 20) & 0xFu; }
#define XB_SPIN(cond, bar) do { unsigned _sp = 0; while (cond) { __builtin_amdgcn_s_sleep(1); \
    if ((++_sp & 255u) == 0u) { if (xb_ld(&(bar)[XB_TMO])) break; if (_sp > XB_SPIN_CAP) { atomicAdd(&(bar)[XB_TMO], 1u); break; } } } } while (0)
struct XcdBarrier { unsigned* bar; unsigned x; volatile LAS unsigned* st; };
__device__ __forceinline__ XcdBarrier xcd_barrier_post(unsigned* bar, volatile LAS unsigned* st) {
    XcdBarrier b; b.bar = bar; b.x = xb_xcc_id(); b.st = st;
    if (threadIdx.x == 0) (void)xb_add(&bar[XB_XCNT(b.x)], 1u);
    return b;
}
__device__ __forceinline__ void xcd_barrier_complete(unsigned* bar, unsigned x, unsigned& nloc, unsigned& nx) {
    const unsigned G = gridDim.x * gridDim.y * gridDim.z;
    unsigned sum, cnt, mine, sp = 0u;
    for (;;) {
        sum = 0u; cnt = 0u; mine = 0u;
#pragma unroll
        for (unsigned j = 0; j < 16; ++j) { const unsigned c = xb_ld(&bar[XB_XCNT(j)]); sum += c; cnt += (c > 0u) ? 1u : 0u; mine = (j == x) ? c : mine; }
        if (sum == G) break;
        __builtin_amdgcn_s_sleep(1);
        if ((++sp & 255u) == 0u) { if (xb_ld(&bar[XB_TMO])) break; if (sp > XB_SPIN_CAP) { atomicAdd(&bar[XB_TMO], 1u); break; } }
    }
    nloc = mine > 0u ? mine : 1u; nx = cnt > 0u ? cnt : 1u;
}
__device__ __forceinline__ void xcd_barrier_leader(const XcdBarrier& b) {
    {
        unsigned* bar = b.bar;
        __builtin_amdgcn_s_waitcnt(0);
        unsigned nloc = b.st[0], nx = b.st[1];
        if (nloc == 0u) { xcd_barrier_complete(bar, b.x, nloc, nx); b.st[0] = nloc; b.st[1] = nx; }
        const unsigned old = xb_add(&bar[XB_XSUB(b.x)], 1u);
        const unsigned gen = old / nloc;
        if (old + 1u == (gen + 1u) * nloc) {
            __builtin_amdgcn_fence(__ATOMIC_RELEASE, "agent");
            asm volatile("s_waitcnt vmcnt(0)" ::: "memory");
            const unsigned og = xb_add(&bar[XB_TOP], 1u);
            const unsigned tg = og / nx;
            if (og + 1u == (tg + 1u) * nx) xb_add(&bar[XB_TOPGEN], 1u);
            else XB_SPIN(xb_ld(&bar[XB_TOPGEN]) == tg, bar);
            __builtin_amdgcn_fence(__ATOMIC_ACQUIRE, "agent");
            xb_add(&bar[XB_XGEN(b.x)], 1u);
            asm volatile("s_waitcnt vmcnt(0)" ::: "memory");
        } else {
            XB_SPIN(xb_ld(&bar[XB_XGEN(b.x)]) == gen, bar);
            __builtin_amdgcn_fence(__ATOMIC_ACQUIRE, "agent");
            asm volatile("s_waitcnt vmcnt(0)" ::: "memory");
        }
    }
}
__device__ __forceinline__ void xcd_barrier(const XcdBarrier& b) {
    asm volatile("s_waitcnt vmcnt(0)" ::: "memory");
    __syncthreads();
    if (threadIdx.x == 0) xcd_barrier_leader(b);
    __syncthreads();
}

struct Args { const float* in[24]; float* out; unsigned char* ws; };
struct Frame {
    LAS unsigned char* lds;
    int G, bx;
};
#define IN_(k) (A.in[k])
#define x_prompt_ IN_(0)
#define x_sample_ IN_(1)
#define cache_k_ IN_(2)
#define cache_v_ IN_(3)
#define c_ IN_(4)
#define c_ctx_ IN_(5)
#define w_ada_ IN_(6)
#define b_ada_ IN_(7)
#define g_pre1_ IN_(8)
#define g_post1_ IN_(9)
#define g_pre2_ IN_(10)
#define g_post2_ IN_(11)
#define w_in_ IN_(12)
#define sink_ IN_(13)
#define w_pool_ IN_(14)
#define pool_scale_ IN_(15)
#define conv_dw_ IN_(16)
#define conv_b_ IN_(17)
#define conv_ln_g_ IN_(18)
#define conv_ln_b_ IN_(19)
#define w_conv_pw_ IN_(20)
#define w_out_ IN_(21)
#define w_mlp1_ IN_(22)
#define w_mlp2_ IN_(23)
#define WSF(off) ((float*)(A.ws + (off)))
#define WSB(off) ((bf16*)(A.ws + (off)))
#define PHASE_IDS() int tid_ = threadIdx.x; asm volatile("" : "+v"(tid_)); const int tid = tid_, lane = tid & 63, wv = __builtin_amdgcn_readfirstlane(tid >> 6); (void)lane; (void)wv
#define DPP_F(old_, v_, ctrl_, rm_) __builtin_bit_cast(float, __builtin_amdgcn_update_dpp(__builtin_bit_cast(int, (float)(old_)), __builtin_bit_cast(int, (float)(v_)), (ctrl_), (rm_), 0xf, false))
__device__ __forceinline__ float wave_sum(float v) {
    v += DPP_F(0.f, v, 0xB1, 0xf);
    v += DPP_F(0.f, v, 0x4E, 0xf);
    v += DPP_F(0.f, v, 0x124, 0xf);
    v += DPP_F(0.f, v, 0x128, 0xf);
    v += DPP_F(0.f, v, 0x142, 0xa);
    v += DPP_F(0.f, v, 0x143, 0xc);
    return __builtin_bit_cast(float, __builtin_amdgcn_readlane(__builtin_bit_cast(int, v), 63));
}

__device__ __forceinline__ void tr_tile(const float* W, int N, bf16* WT, int ldt, int k0, int n0, LAS float* scr, int lane) {
    const int kq = lane >> 4, n4 = (lane & 15) * 4;
#pragma unroll 4
    for (int i = 0; i < 16; ++i) { const int kk = 4 * i + kq; const f32x4 v = *(const f32x4*)(W + (size_t)(k0 + kk) * N + n0 + n4);
        LAS float* d = scr + kk * 65 + n4; d[0] = v[0]; d[1] = v[1]; d[2] = v[2]; d[3] = v[3]; }
    LDS_WAIT(); asm volatile("" ::: "memory");
    const int c = lane & 7;
#pragma unroll
    for (int j = 0; j < 8; ++j) { const int n = (lane >> 3) + 8 * j; const LAS float* s = scr + (8 * c) * 65 + n;
        v4u o; o.x = pk2(s[0 * 65], s[1 * 65]); o.y = pk2(s[2 * 65], s[3 * 65]); o.z = pk2(s[4 * 65], s[5 * 65]); o.w = pk2(s[6 * 65], s[7 * 65]);
        *(v4u*)(WT + (size_t)(n0 + n) * ldt + k0 + 8 * c) = o; }
    LDS_WAIT(); asm volatile("" ::: "memory");
}
__device__ __forceinline__ void p0a(Frame& F, const Args& A) {
    PHASE_IDS();
    {
        LAS float* S = (LAS float*)F.lds;
        LAS float* RED = (LAS float*)(F.lds + 24576);
        for (int i = tid; i < 3 * DM; i += NWAVES * 64) { const int cv = i / DM, k = i % DM; const float v = (cv == 0) ? c_ctx_[k] : c_[(cv - 1) * DM + k]; S[i] = v / (1.f + expf(-v)); }
        __syncthreads();
        for (int rp_ = 0; rp_ < DUPN(14); ++rp_) for (int it = F.bx; it < DEPTH * 48 * 8; it += F.G) {
            const int l = it / 384, rem = it % 384, cc = rem >> 3, kp = rem & 7;
            const int kb = kp * 256 + wv * 32;
            const float* W = w_ada_ + ((size_t)l * DM + kb) * ADA + cc * 256 + lane * 4;
            f32x4 a0 = {0.f, 0.f, 0.f, 0.f}, a1 = a0, a2 = a0;
#pragma unroll 8
            for (int r = 0; r < 32; ++r) { const f32x4 w = *(const f32x4*)(W + (size_t)r * ADA); const float s0 = S[kb + r], s1 = S[DM + kb + r], s2 = S[2 * DM + kb + r];
                a0 += w * s0; a1 += w * s1; a2 += w * s2; }
            *(LAS f32x4*)(RED + (wv * 3 + 0) * 256 + lane * 4) = a0; *(LAS f32x4*)(RED + (wv * 3 + 1) * 256 + lane * 4) = a1; *(LAS f32x4*)(RED + (wv * 3 + 2) * 256 + lane * 4) = a2;
            __syncthreads();
            for (int o = tid; o < 768; o += NWAVES * 64) { const int cv = o >> 8, col = o & 255; float s = 0.f;
#pragma unroll
                for (int w8 = 0; w8 < 8; ++w8) s += RED[(w8 * 3 + cv) * 256 + col];
                WSF(WS_MODP)[((size_t)(kp * DEPTH + l) * 3 + cv) * ADA + cc * 256 + col] = s; }
            __syncthreads();
        }
    }
    asm volatile("s_waitcnt vmcnt(0)" ::: "memory");
    __syncthreads();
    if (tid == 0) { __builtin_amdgcn_fence(__ATOMIC_RELEASE, "agent"); (void)xb_add((unsigned*)(A.ws + WS_CTL) + CW_GEMV, 1u); }
    {
        LAS float* scr = (LAS float*)(F.lds + wv * 16640);
        const int gw = F.bx * NWAVES + wv, NGW = F.G * NWAVES;
        constexpr int T_IN = 32 * 48, T_OUT = 32 * 32, T_1 = 32 * 128, T_2 = 128 * 32, T_L = T_IN + T_OUT + T_1 + T_2;
#define TR_DEC(r_, nnb_, kb_, nb_) do { const int blk_ = (r_) >> 3, in_ = (r_) & 7, bn_ = blk_ % ((nnb_) / 4), bk_ = blk_ / ((nnb_) / 4); kb_ = 2 * bk_ + (in_ >> 2); nb_ = 4 * bn_ + (in_ & 3); } while (0)
        for (int rp_ = 0; rp_ < DUPN(15); ++rp_) for (int it = gw; it < DEPTH * T_L; it += NGW) {
            const int l = it / T_L; int r = it % T_L;
            if (r < T_IN) { int kb, nb; TR_DEC(r, 48, kb, nb); tr_tile(w_in_ + (size_t)l * DM * INW, INW, WSB(WS_WIN) + (size_t)l * INW * DM, DM, kb * 64, nb * 64, scr, lane); continue; } r -= T_IN;
            if (r < T_OUT) { int kb, nb; TR_DEC(r, 32, kb, nb);
                if (kb < 16) tr_tile(w_out_ + (size_t)l * DM * DM, DM, WSB(WS_WOUT) + (size_t)l * DM * DM, DM, kb * 64, nb * 64, scr, lane);
                else tr_tile(w_out_ + (size_t)l * DM * DM + (size_t)1024 * DM, DM, WSB(WS_WOT2) + (size_t)l * DM * 1024, 1024, (kb - 16) * 64, nb * 64, scr, lane);
                continue; } r -= T_OUT;
            if (r < T_1) { int kb, nb; TR_DEC(r, 128, kb, nb); tr_tile(w_mlp1_ + (size_t)l * DM * DFF, DFF, WSB(WS_W1) + (size_t)l * DFF * DM, DM, kb * 64, nb * 64, scr, lane); continue; } r -= T_1;
            { int kb, nb; TR_DEC(r, 32, kb, nb); tr_tile(w_mlp2_ + (size_t)l * DFF * DM, DM, WSB(WS_W2) + (size_t)l * DM * DFF, DFF, kb * 64, nb * 64, scr, lane); }
        }
    }
    const int gt = F.bx * (NWAVES * 64) + tid, NGT = F.G * NWAVES * 64;
    for (int i = gt; i < 2 * 262144; i += NGT) {
        const int which = i >> 18, o4 = i & 262143;
        const int d4 = o4 & 15, key = (o4 >> 4) & 511, kvh = (o4 >> 13) & 3, bl = o4 >> 15;
        const float* src = (which ? cache_v_ : cache_k_) + (((size_t)bl * 512 + key) * 4 + kvh) * 64 + d4 * 4;
        const f32x4 v = *(const f32x4*)src; v2u o; o.x = pk2(v[0], v[1]); o.y = pk2(v[2], v[3]);
        *(v2u*)((which ? WSB(WS_VC) : WSB(WS_KC)) + (size_t)o4 * 4) = o;
    }
    for (int i = gt; i < 1536; i += NGT) {
        const int fi = i & 15, p = (i < 512) ? (i >> 4) : ((i - 512) >> 4);
        const float inv = 1.0f / powf(10000.0f, (float)fi * (1.0f / 16.0f));
        const float ang = (float)p * inv;
        const float kq = rintf(ang * 0.15915494309189535f);
        float rr = fmaf(-kq, 6.2831854820251465f, ang); rr = fmaf(-kq, -1.7484555e-7f, rr);
        const float cs = cosf(rr), sn = sinf(rr);
        if (i < 512) { WSF(WS_ROPE)[i] = cs; WSF(WS_ROPE)[512 + i] = sn; } else { WSF(WS_ROPE)[1024 + (i - 512)] = cs; WSF(WS_ROPE)[2048 + (i - 512)] = sn; }
    }
    for (int i = gt; i < DEPTH * 1024 * 128; i += NGT) {
        const int j8 = (i & 127) * 8, k = (i >> 7) & 1023, l = i >> 17;
        float v[8];
#pragma unroll
        for (int e = 0; e < 8; ++e) v[e] = 0.f;
        if (k < 512) { const int g = k >> 7; if ((j8 >> 7) == g) { const float* wp = w_pool_ + (((size_t)l * 4 + g) * 128 + (k & 127)) * 128 + (j8 & 127); const float* ps = pool_scale_ + l * 512 + j8;
#pragma unroll
                for (int e = 0; e < 8; ++e) v[e] = wp[e] * ps[e]; } }
        else if (j8 >= 512) { const float* wp = w_conv_pw_ + ((size_t)l * 512 + (k - 512)) * 512 + (j8 - 512);
#pragma unroll
            for (int e = 0; e < 8; ++e) v[e] = wp[e]; }
        v4u o; o.x = pk2(v[0], v[1]); o.y = pk2(v[2], v[3]); o.z = pk2(v[4], v[5]); o.w = pk2(v[6], v[7]);
        *(v4u*)(WSB(WS_WBD) + ((size_t)l * 1024 + k) * 1024 + j8) = o;
    }
    if (tid == 0) { unsigned* cnt = (unsigned*)(A.ws + WS_CTL) + CW_GEMV; unsigned sp = 0u;
        while (xb_ld(cnt) < (unsigned)F.G) { __builtin_amdgcn_s_sleep(1); if (++sp > (1u << 22)) break; }
        __builtin_amdgcn_fence(__ATOMIC_ACQUIRE, "agent"); }
    __syncthreads();
    for (int i = gt; i < DEPTH * 3 * ADA; i += NGT) { const int j = i % ADA, lc = i / ADA, l = lc / 3, cv = lc % 3;
        float sacc = b_ada_[(size_t)l * ADA + j];
#pragma unroll
        for (int kp = 0; kp < 8; ++kp) sacc += WSF(WS_MODP)[((size_t)(kp * DEPTH + l) * 3 + cv) * ADA + j];
        WSF(WS_MODS)[i] = sacc; }
}

template <bool PART> __device__ __forceinline__ float mod_val(Frame& F, const Args& A, int l, int cv, int j) {
    if (!PART) return WSF(WS_MODS)[((size_t)l * 3 + cv) * ADA + j];
    float s = b_ada_[(size_t)l * ADA + j];
#pragma unroll
    for (int kp = 0; kp < 8; ++kp) s += WSF(WS_MODP)[((size_t)(kp * DEPTH + l) * 3 + cv) * ADA + j];
    return s;
}
template <int MODE, bool PART, int STAGE = 0>
__device__ __forceinline__ void thin_phase(Frame& F, const Args& A, const float* gpost, int gate_off, int l_gate, const float* gpre, int sc_off, int sh_off, int l_mod, bool x_from_inputs, const XcdBarrier* barp = nullptr) {
    PHASE_IDS();
    LAS float* PA = (LAS float*)F.lds; LAS float* PB = PA + 3 * DM; LAS float* PC = PB + 3 * DM;
    if (STAGE == 4) {
        asm volatile("s_waitcnt vmcnt(0)" ::: "memory");
        __syncthreads();
        if (wv == 0) { if (tid == 0) xcd_barrier_leader(*barp); }
        else {
#pragma unroll
            for (int k = 0; k < 14; ++k) { const int i = (tid - 64) + 448 * k; if (i < 3 * DM) { const int cv = i / DM, c = i % DM;
                if (MODE != 0) PA[i] = mod_val<PART>(F, A, l_gate, cv, gate_off + c) * gpost[c];
                if (MODE != 2) { PB[i] = gpre[c] * (1.f + mod_val<PART>(F, A, l_mod, cv, sc_off + c)); PC[i] = mod_val<PART>(F, A, l_mod, cv, sh_off + c); } } }
        }
    }
    if (STAGE != 2 && STAGE != 4) {
#pragma unroll
    for (int k = 0; k < 12; ++k) { const int i = tid + 512 * k, cv = i / DM, c = i % DM;
        if (MODE != 0) PA[i] = mod_val<PART>(F, A, l_gate, cv, gate_off + c) * gpost[c];
        if (MODE != 2) { PB[i] = gpre[c] * (1.f + mod_val<PART>(F, A, l_mod, cv, sc_off + c)); PC[i] = mod_val<PART>(F, A, l_mod, cv, sh_off + c); } }
    }
    if (STAGE == 1) return;
    __syncthreads();
    const int nchk = (MODE == 0) ? (F.bx < 128 ? 2 : 4) : 3;
    for (int ci = 0; ci < nchk; ++ci) { const int ch = (MODE == 0) ? (F.bx < 128 ? 2 * F.bx + ci : 256 + 4 * (F.bx - 128) + ci) : F.bx + 256 * ci;
#pragma unroll
        for (int rr = 0; rr < 2; ++rr) {
            const int row = ch * 16 + wv * 2 + rr;
            const int cv = row < MP ? 0 : (row < MP + SEQ_S ? 1 : 2);
            f32x4 xv[8];
            if (x_from_inputs) { const float* xin = row < MP ? x_prompt_ + (size_t)row * DM : x_sample_ + (size_t)(row - MP) * DM;
#pragma unroll
                for (int j = 0; j < 8; ++j) xv[j] = *(const f32x4*)(xin + 512 * (j >> 1) + 8 * lane + 4 * (j & 1)); }
            else { const bf16* xb = WSB(WS_XB) + (size_t)row * DM;
#pragma unroll
                for (int jj = 0; jj < 4; ++jj) { const v4u w = *(const v4u*)(xb + 512 * jj + 8 * lane);
                    xv[2 * jj] = (f32x4){bflo(w.x), bfhi(w.x), bflo(w.y), bfhi(w.y)}; xv[2 * jj + 1] = (f32x4){bflo(w.z), bfhi(w.z), bflo(w.w), bfhi(w.w)}; } }
            if (MODE != 0) {
                const bf16* mp = WSB(WS_MIX) + (size_t)row * DM; f32x4 mv[8]; float ss = 0.f;
#pragma unroll
                for (int jj = 0; jj < 4; ++jj) { const v4u w = *(const v4u*)(mp + 512 * jj + 8 * lane);
                    mv[2 * jj] = (f32x4){bflo(w.x), bfhi(w.x), bflo(w.y), bfhi(w.y)}; mv[2 * jj + 1] = (f32x4){bflo(w.z), bfhi(w.z), bflo(w.w), bfhi(w.w)}; }
                if (row >= MP) { const bf16* mp2 = WSB(WS_MIX2) + (size_t)(row - MP) * DM;
#pragma unroll
                    for (int jj = 0; jj < 4; ++jj) { const v4u w = *(const v4u*)(mp2 + 512 * jj + 8 * lane);
                        mv[2 * jj] = mv[2 * jj] + (f32x4){bflo(w.x), bfhi(w.x), bflo(w.y), bfhi(w.y)}; mv[2 * jj + 1] = mv[2 * jj + 1] + (f32x4){bflo(w.z), bfhi(w.z), bflo(w.w), bfhi(w.w)}; } }
#pragma unroll
                for (int j = 0; j < 8; ++j) ss += (mv[j][0] * mv[j][0] + mv[j][1] * mv[j][1]) + (mv[j][2] * mv[j][2] + mv[j][3] * mv[j][3]);
                const float r1 = __builtin_amdgcn_rsqf(wave_sum(ss) * (1.0f / DM) + EPS);
#pragma unroll
                for (int j = 0; j < 8; ++j) { const int co = 512 * (j >> 1) + 8 * lane + 4 * (j & 1); const f32x4 pa = *(const LAS f32x4*)(PA + cv * DM + co); xv[j] = xv[j] + pa * (mv[j] * r1); }
                if (MODE == 2) { float* xo = A.out + (size_t)row * DM;
#pragma unroll
                    for (int j = 0; j < 8; ++j) *(f32x4*)(xo + 512 * (j >> 1) + 8 * lane + 4 * (j & 1)) = xv[j]; }
                else { bf16* xo = WSB(WS_XB) + (size_t)row * DM;
#pragma unroll
                    for (int jj = 0; jj < 4; ++jj) { v4u o; o.x = pk2(xv[2 * jj][0], xv[2 * jj][1]); o.y = pk2(xv[2 * jj][2], xv[2 * jj][3]); o.z = pk2(xv[2 * jj + 1][0], xv[2 * jj + 1][1]); o.w = pk2(xv[2 * jj + 1][2], xv[2 * jj + 1][3]);
                        *(v4u*)(xo + 512 * jj + 8 * lane) = o; } }
            }
            if (MODE != 2) {
                float ss = 0.f;
#pragma unroll
                for (int j = 0; j < 8; ++j) ss += (xv[j][0] * xv[j][0] + xv[j][1] * xv[j][1]) + (xv[j][2] * xv[j][2] + xv[j][3] * xv[j][3]);
                const float r2 = __builtin_amdgcn_rsqf(wave_sum(ss) * (1.0f / DM) + EPS);
                bf16* hp = WSB(WS_H) + (size_t)row * DM;
#pragma unroll
                for (int jj = 0; jj < 4; ++jj) { const int co = 512 * jj + 8 * lane;
                    const f32x4 pb0 = *(const LAS f32x4*)(PB + cv * DM + co), pb1 = *(const LAS f32x4*)(PB + cv * DM + co + 4), pc0 = *(const LAS f32x4*)(PC + cv * DM + co), pc1 = *(const LAS f32x4*)(PC + cv * DM + co + 4);
                    const f32x4 h0 = (xv[2 * jj] * r2) * pb0 + pc0, h1 = (xv[2 * jj + 1] * r2) * pb1 + pc1;
                    v4u o; o.x = pk2(h0[0], h0[1]); o.y = pk2(h0[2], h0[3]); o.z = pk2(h1[0], h1[1]); o.w = pk2(h1[2], h1[3]); *(v4u*)(hp + co) = o; }
            }
        }
    }
    __syncthreads();
}

#define MFMA32(a, b, c) __builtin_amdgcn_mfma_f32_32x32x16_bf16((a), (b), (c), 0, 0, 0)
__device__ __forceinline__ int crow(int reg, int h) { return (reg & 3) + 8 * (reg >> 2) + 4 * h; }
constexpr int KS_LD = 72, VT_LD = 136;
template <bool LAT>
__device__ __forceinline__ void attn_unit(Frame& F, const Args& A, int layer, int unit) {
    LAS bf16* Ks = (LAS bf16*)F.lds; LAS bf16* Vt = (LAS bf16*)(F.lds + 128 * KS_LD * 2);
    asm volatile("" : "+s"(unit));
    PHASE_IDS(); const int w = wv, r = lane & 31, h = lane >> 5;
    int b, kvh, tq, qpos0 = 0, nb = 0;
    if (LAT) { kvh = unit & 3; nb = (unit >> 2) & 15; b = unit >> 6; qpos0 = nb * 128 + 32 * (w & 3); tq = MP + b * SEQ_S + qpos0; }
    else { const int half = unit & 1; kvh = (unit >> 1) & 3; b = unit >> 3; tq = b * SEQ_P + half * 128 + 32 * (w & 3); }
    const int hq0 = kvh * 4 + (w >> 2);
    bf16x8 q[2][4];
#pragma unroll
    for (int t = 0; t < 2; ++t) {
        v4u qraw[4];
        { const bf16* qp = WSB(WS_QKV) + ((size_t)(hq0 + 2 * t) * M + (size_t)(tq + r)) * 64 + 8 * h;
#pragma unroll
          for (int s = 0; s < 4; ++s) qraw[s] = *(const v4u*)(qp + 16 * s); }
        if (LAT) {
            const int pos = qpos0 + r;
#pragma unroll
            for (int hf = 0; hf < 2; ++hf) {
                const float* ct = WSF(WS_ROPE) + (hf ? 1024 + (pos & 63) * 16 : (pos >> 6) * 16) + 8 * h; const float* st = ct + (hf ? 1024 : 512);
#pragma unroll
                for (int jj = 0; jj < 4; ++jj) { const float c0 = ct[2 * jj], c1 = ct[2 * jj + 1], s0 = st[2 * jj], s1 = st[2 * jj + 1];
                    const unsigned a = qraw[2 * hf][jj], bb = qraw[2 * hf + 1][jj];
                    const float u1l = bflo(a), u1h = bfhi(a), u2l = bflo(bb), u2h = bfhi(bb);
                    qraw[2 * hf][jj] = pk2(u1l * c0 - u2l * s0, u1h * c1 - u2h * s1); qraw[2 * hf + 1][jj] = pk2(u2l * c0 + u1l * s0, u2h * c1 + u1h * s1); }
            }
        }
#pragma unroll
        for (int s = 0; s < 4; ++s) q[t][s] = __builtin_bit_cast(bf16x8, qraw[s]);
    }
    f32x16 O[2][2];
#pragma unroll
    for (int t = 0; t < 2; ++t)
#pragma unroll
        for (int i = 0; i < 16; ++i) { O[t][0][i] = 0.f; O[t][1][i] = 0.f; }
    float mrun[2], lsum[2];
#pragma unroll
    for (int t = 0; t < 2; ++t) { mrun[t] = sink_[layer * 16 + hq0 + 2 * t] * LOG2E; lsum[t] = 1.0f; }
    constexpr float C2 = 0.125f * LOG2E;
    const int nch = LAT ? 7 : 2;
#define ATT_DESC(ci_, kb_, vb_, pitch_, rope_, kpos0_) do { \
        if (LAT) { if ((ci_) < 3) { const int j_ = nb - 1 + (ci_); const size_t row0_ = (size_t)MP + (size_t)b * SEQ_S + (size_t)j_ * 128; \
                kb_ = WSB(WS_QKV) + ((size_t)(16 + kvh) * M + row0_) * 64; vb_ = WSB(WS_QKV) + ((size_t)(20 + kvh) * M + row0_) * 64; pitch_ = 64; rope_ = true; kpos0_ = j_ * 128; } \
            else { const size_t off_ = ((size_t)((b * DEPTH + layer) * 4 + kvh) * 512 + (size_t)((ci_) - 3) * 128) * 64; kb_ = WSB(WS_KC) + off_; vb_ = WSB(WS_VC) + off_; pitch_ = 64; rope_ = false; kpos0_ = 0; } } \
        else { const size_t row0_ = (size_t)b * SEQ_P + (size_t)(ci_) * 128; kb_ = WSB(WS_QKV) + ((size_t)(16 + kvh) * M + row0_) * 64; vb_ = WSB(WS_QKV) + ((size_t)(20 + kvh) * M + row0_) * 64; pitch_ = 64; rope_ = false; kpos0_ = 0; } } while (0)
    const int skey = tid >> 2, spr = tid & 3, sc0 = (spr >> 1) * 32 + (spr & 1) * 8, vkey = (w & 1) * 64 + lane, vc = w >> 1;
    v4u pka, pkb, pv0, pv1;
    LAS float* RT = (LAS float*)(F.lds + 36864);
    if (LAT) { for (int i = tid; i < 768; i += 512) *(LAS f32x4*)(RT + 4 * i) = *(const f32x4*)(WSF(WS_ROPE) + 4 * i); }
#define ATT_LOAD(kb_, vb_, pitch_, rope_, kpos0_) do { \
        const bf16* src_ = (kb_) + (size_t)skey * (pitch_) + sc0; pka = *(const v4u*)src_; pkb = *(const v4u*)(src_ + 16); \
        pv0 = *(const v4u*)((vb_) + (size_t)vkey * (pitch_) + 8 * vc); pv1 = *(const v4u*)((vb_) + (size_t)vkey * (pitch_) + 8 * (vc + 4)); \
        } while (0)
    f32x16 XB;
#pragma unroll
    for (int i = 0; i < 16; ++i) XB[i] = 0.f;
    int ci = (LAT && nb == 0) ? 1 : 0;
    const bf16 *kb, *vb; int pitch; bool rope; int kpos0;
    ATT_DESC(ci, kb, vb, pitch, rope, kpos0);
    ATT_LOAD(kb, vb, pitch, rope, kpos0);
    for (;;) {
        __syncthreads();
        if (rope) {
            const int kpos_ = kpos0 + skey; const LAS float* ct_ = RT + ((spr >> 1) ? 1024 + (kpos_ & 63) * 16 : (kpos_ >> 6) * 16) + 8 * (spr & 1); const LAS float* st_ = ct_ + ((spr >> 1) ? 1024 : 512);
            const f32x4 pct0 = *(const LAS f32x4*)ct_, pct1 = *(const LAS f32x4*)(ct_ + 4), pst0 = *(const LAS f32x4*)st_, pst1 = *(const LAS f32x4*)(st_ + 4);
            const float cc[8] = {pct0[0], pct0[1], pct0[2], pct0[3], pct1[0], pct1[1], pct1[2], pct1[3]}, sn[8] = {pst0[0], pst0[1], pst0[2], pst0[3], pst1[0], pst1[1], pst1[2], pst1[3]};
            v4u o1, o2;
#pragma unroll
            for (int jj = 0; jj < 4; ++jj) { const float c0f = cc[2 * jj], c1f = cc[2 * jj + 1], s0f = sn[2 * jj], s1f = sn[2 * jj + 1];
                const float u1l = bflo(pka[jj]), u1h = bfhi(pka[jj]), u2l = bflo(pkb[jj]), u2h = bfhi(pkb[jj]);
                o1[jj] = pk2(u1l * c0f - u2l * s0f, u1h * c1f - u2h * s1f); o2[jj] = pk2(u2l * c0f + u1l * s0f, u2h * c1f + u1h * s1f); }
            *(LAS v4u*)(Ks + skey * KS_LD + sc0) = o1; *(LAS v4u*)(Ks + skey * KS_LD + sc0 + 16) = o2;
        } else { *(LAS v4u*)(Ks + skey * KS_LD + sc0) = pka; *(LAS v4u*)(Ks + skey * KS_LD + sc0 + 16) = pkb; }
#pragma unroll
        for (int e = 0; e < 4; ++e) { Vt[(8 * vc + 2 * e) * VT_LD + vkey] = (bf16)(pv0[e] & 0xffffu); Vt[(8 * vc + 2 * e + 1) * VT_LD + vkey] = (bf16)(pv0[e] >> 16);
            Vt[(8 * (vc + 4) + 2 * e) * VT_LD + vkey] = (bf16)(pv1[e] & 0xffffu); Vt[(8 * (vc + 4) + 2 * e + 1) * VT_LD + vkey] = (bf16)(pv1[e] >> 16); }
        __syncthreads();
        const bool mask = rope; const int mpos0 = kpos0;
        int nci = ci + 1; if (LAT && nci == 2 && nb == 15) nci = 3;
        const bool has_next = nci < nch;
        if (has_next) { ATT_DESC(nci, kb, vb, pitch, rope, kpos0); ATT_LOAD(kb, vb, pitch, rope, kpos0); }
        const int wj = w & 3;
        const int kt_lo = (LAT && mask && ci == 0) ? wj : 0, kt_hi = (LAT && mask && ci == 2) ? wj + 1 : 4;
#pragma unroll 1
        for (int kt = kt_lo; kt < kt_hi; ++kt) {
            const bool dmask = LAT && mask && ci != 1 && kt == wj;
            if (LAT) { if (dmask) {
#pragma unroll
                for (int i = 0; i < 16; ++i) { const int rel = (mpos0 + 32 * kt + crow(i, h)) - (qpos0 + r); XB[i] = (rel > 128 || rel < -128) ? -1.0e30f : 0.f; } } }
            bf16x8 kf[4];
#pragma unroll
            for (int s = 0; s < 4; ++s) kf[s] = *(const LAS bf16x8*)(Ks + (32 * kt + r) * KS_LD + 16 * s + 8 * h);
            bf16x8 vf[2][2];
#pragma unroll
            for (int s = 0; s < 2; ++s) {
                const LAS bf16* v0p = Vt + r * VT_LD + 32 * kt + 16 * s + 4 * h; const LAS bf16* v1p = v0p + 32 * VT_LD;
                const s16x4 a0 = *(const LAS s16x4*)v0p, a1 = *(const LAS s16x4*)(v0p + 8), b0 = *(const LAS s16x4*)v1p, b1 = *(const LAS s16x4*)(v1p + 8);
                vf[0][s] = __builtin_shufflevector(a0, a1, 0, 1, 2, 3, 4, 5, 6, 7); vf[1][s] = __builtin_shufflevector(b0, b1, 0, 1, 2, 3, 4, 5, 6, 7);
            }
#pragma unroll
            for (int t = 0; t < 2; ++t) {
                f32x16 X;
                if (LAT) X = XB;
                else {
#pragma unroll
                    for (int i = 0; i < 16; ++i) X[i] = 0.f; }
#pragma unroll
                for (int s = 0; s < 4; ++s) X = MFMA32(kf[s], q[t][s], X);
                float p[16]; float mx = -3.0e38f;
#pragma unroll
                for (int i = 0; i < 16; ++i) { float v = X[i];
                    p[i] = v; mx = fmaxf(mx, v); }
                mx = fmaxf(mx, __shfl_xor(mx, 32));
                const float mrun_old = mrun[t]; const float mnew = fmaxf(mrun_old, mx * C2), alpha = __builtin_amdgcn_exp2f(mrun_old - mnew);
                float rs = 0.f;
#pragma unroll
                for (int i = 0; i < 16; ++i) { p[i] = __builtin_amdgcn_exp2f(fmaf(p[i], C2, -mnew)); rs += p[i]; }
                rs += __shfl_xor(rs, 32);
                lsum[t] = lsum[t] * alpha + rs; mrun[t] = mnew;
                if (__builtin_amdgcn_ballot_w64(mnew != mrun_old) != 0ull) {
#pragma unroll
                    for (int i = 0; i < 16; ++i) { O[t][0][i] *= alpha; O[t][1][i] *= alpha; } }
                v4u p0, p1;
#pragma unroll
                for (int jj = 0; jj < 4; ++jj) { p0[jj] = pk2(p[2 * jj], p[2 * jj + 1]); p1[jj] = pk2(p[8 + 2 * jj], p[9 + 2 * jj]); }
                const bf16x8 pf0 = __builtin_bit_cast(bf16x8, p0), pf1 = __builtin_bit_cast(bf16x8, p1);
                O[t][0] = MFMA32(vf[0][0], pf0, O[t][0]); O[t][1] = MFMA32(vf[1][0], pf0, O[t][1]);
                O[t][0] = MFMA32(vf[0][1], pf1, O[t][0]); O[t][1] = MFMA32(vf[1][1], pf1, O[t][1]);
            }
            if (LAT) { if (dmask) {
#pragma unroll
                for (int i = 0; i < 16; ++i) XB[i] = 0.f; } }
        }
        if (!has_next) break;
        ci = nci;
    }
#undef ATT_DESC
#undef ATT_LOAD
#pragma unroll
    for (int t = 0; t < 2; ++t) {
        const float inv = 1.0f / lsum[t];
        bf16* op = WSB(WS_MIXCAT) + (size_t)(tq + r) * DM + (hq0 + 2 * t) * 64 + 4 * h;
#pragma unroll
        for (int gi = 0; gi < 4; ++gi) {
            v2u o; o.x = pk2(O[t][0][4 * gi] * inv, O[t][0][4 * gi + 1] * inv); o.y = pk2(O[t][0][4 * gi + 2] * inv, O[t][0][4 * gi + 3] * inv); *(v2u*)(op + 8 * gi) = o;
            v2u o2; o2.x = pk2(O[t][1][4 * gi] * inv, O[t][1][4 * gi + 1] * inv); o2.y = pk2(O[t][1][4 * gi + 2] * inv, O[t][1][4 * gi + 3] * inv); *(v2u*)(op + 32 + 8 * gi) = o2;
        }
    }
}

template <int HW> __device__ __forceinline__ void pool_g(const Args& A, const LAS bf16* RAW, int S, int s0, int t0, int c) {
    constexpr int W = 2 * HW; float u[32 + W];
#pragma unroll
    for (int jj = 0; jj < 32 + W; ++jj) u[jj] = bf2f(RAW[(8 - HW + jj) * 512 + c]);
    float sum = 0.f;
#pragma unroll
    for (int jj = 0; jj < W; ++jj) sum += u[jj];
    const bool interior = (s0 >= HW) && (s0 + 31 + HW <= S);
    bf16* op = WSB(WS_MIXCAT) + (size_t)t0 * DM + 1024 + c;
#pragma unroll
    for (int o = 0; o < 32; ++o) {
        float rc = 1.0f / (float)W;
        if (!interior) { const int so = s0 + o; const int lo = so - HW > 0 ? so - HW : 0, hi = so + HW < S ? so + HW : S; rc = __builtin_amdgcn_rcpf((float)(hi - lo)); }
        const float pooled = fmaf(sum, rc, -u[o + HW]);
        const unsigned pk = pk2(pooled, 0.f); op[(size_t)o * DM] = (bf16)(pk & 0xffffu);
        if (o < 31) sum += u[o + W] - u[o]; }
}
__device__ __forceinline__ void convpool_tile(Frame& F, const Args& A, int layer, int ti) {
    asm volatile("" : "+s"(ti));
    const int t0 = ti * 32; int seq0, S;
    if (t0 < MP) { seq0 = t0 & ~(SEQ_P - 1); S = SEQ_P; } else { seq0 = MP + ((t0 - MP) & ~(SEQ_S - 1)); S = SEQ_S; }
    PHASE_IDS(); const int s0 = t0 - seq0, c = tid;
    LAS bf16* RAW = (LAS bf16*)F.lds;
    __syncthreads();
    {
        v4u st[6];
#pragma unroll
        for (int k = 0; k < 6; ++k) { const int i = tid + 512 * k, row = i >> 6, ch8 = (i & 63) * 8, s = s0 - 8 + row, sc = s < 0 ? 0 : (s >= S ? S - 1 : s);
            st[k] = *(const v4u*)(WSB(WS_Z) + (size_t)(seq0 + sc) * INW + OPU + ch8); if (s != sc) st[k] = (v4u){0u, 0u, 0u, 0u}; }
#pragma unroll
        for (int k = 0; k < 6; ++k) { const int i = tid + 512 * k, row = i >> 6, ch8 = (i & 63) * 8; *(LAS v4u*)(RAW + row * 512 + ch8) = st[k]; }
    }
    const bool prompt = t0 < MP;
    v4u pf[16];
    if (prompt) {
#pragma unroll
        for (int k = 0; k < 16; ++k) { const int i = tid + 512 * k, row = (i >> 7) < 62 ? (i >> 7) : 61, ch8 = (i & 127) * 8, s = s0 - 15 + row, sc = s < 0 ? 0 : (s >= S ? S - 1 : s);
            pf[k] = *(const v4u*)(WSB(WS_Z) + (size_t)(seq0 + sc) * INW + OCA + ch8); }
    } else {
#pragma unroll
        for (int k = 0; k < 4; ++k) { const int i = tid + 512 * k, row = i >> 7, ch8 = (i & 127) * 8, s = s0 - 15 + row, sc = s < 0 ? 0 : (s >= S ? S - 1 : s);
            const bf16* pp = WSB(WS_ZP) + (size_t)(seq0 - MP + sc) * 1024 + ch8;
#pragma unroll
            for (int qk = 0; qk < 4; ++qk) pf[4 * k + qk] = *(const v4u*)(pp + (size_t)qk * MS * 1024); }
    }
    __syncthreads();
    switch (c >> 7) { case 0: pool_g<1>(A, RAW, S, s0, t0, c); break; case 1: pool_g<2>(A, RAW, S, s0, t0, c); break; case 2: pool_g<4>(A, RAW, S, s0, t0, c); break; default: pool_g<8>(A, RAW, S, s0, t0, c); break; }
    __syncthreads();
    if (prompt) {
#pragma unroll
        for (int k = 0; k < 16; ++k) { const int i = tid + 512 * k, row = i >> 7, ch8 = (i & 127) * 8, s = s0 - 15 + row; v4u v = pf[k]; if (s < 0 || s >= S) v = (v4u){0u, 0u, 0u, 0u}; if (row < 62) *(LAS v4u*)(RAW + row * 1024 + ch8) = v; }
    } else {
#pragma unroll 1
        for (int kb = 0; kb < 4; ++kb) {
            if (kb > 0) {
#pragma unroll
                for (int k = 0; k < 4; ++k) { const int i = tid + 512 * (4 * kb + k), row = (i >> 7) < 62 ? (i >> 7) : 61, ch8 = (i & 127) * 8, s = s0 - 15 + row, sc = s < 0 ? 0 : (s >= S ? S - 1 : s);
                    const bf16* pp = WSB(WS_ZP) + (size_t)(seq0 - MP + sc) * 1024 + ch8;
#pragma unroll
                    for (int qk = 0; qk < 4; ++qk) pf[4 * k + qk] = *(const v4u*)(pp + (size_t)qk * MS * 1024); }
            }
#pragma unroll
            for (int k = 0; k < 4; ++k) { const int i = tid + 512 * (4 * kb + k), row = i >> 7, ch8 = (i & 127) * 8, s = s0 - 15 + row;
                float acc8[8];
#pragma unroll
                for (int e = 0; e < 8; ++e) acc8[e] = 0.f;
#pragma unroll
                for (int qk = 0; qk < 4; ++qk)
#pragma unroll
                    for (int e = 0; e < 4; ++e) { acc8[2 * e] += bflo(pf[4 * k + qk][e]); acc8[2 * e + 1] += bfhi(pf[4 * k + qk][e]); }
                v4u v; v.x = pk2(acc8[0], acc8[1]); v.y = pk2(acc8[2], acc8[3]); v.z = pk2(acc8[4], acc8[5]); v.w = pk2(acc8[6], acc8[7]);
                if (s < 0 || s >= S) v = (v4u){0u, 0u, 0u, 0u};
                if (row < 62) *(LAS v4u*)(RAW + row * 1024 + ch8) = v; }
        }
    }
    float wt[31], hv[62];
#pragma unroll
    for (int j = 0; j < 31; ++j) wt[j] = conv_dw_[((size_t)layer * 31 + j) * 512 + c];
    const float cb = conv_b_[layer * 512 + c];
    __syncthreads();
#pragma unroll
    for (int jj = 0; jj < 62; ++jj) { const float a = bf2f(RAW[jj * 1024 + c]), g = bf2f(RAW[jj * 1024 + 512 + c]); hv[jj] = a * __builtin_amdgcn_rcpf(1.f + __expf(-g)); }
    float acc[32];
#pragma unroll
    for (int o = 0; o < 32; ++o) { float a = cb;
#pragma unroll
        for (int j = 0; j < 31; ++j) a = fmaf(hv[o + j], wt[j], a);
        acc[o] = a; }
    LAS float* CT = (LAS float*)F.lds;
    __syncthreads();
#pragma unroll
    for (int o = 0; o < 32; ++o) CT[o * 512 + c] = acc[o];
    __syncthreads();
    f32x4 lg0 = *(const f32x4*)(conv_ln_g_ + layer * 512 + 8 * lane), lg1 = *(const f32x4*)(conv_ln_g_ + layer * 512 + 8 * lane + 4);
    f32x4 lb0 = *(const f32x4*)(conv_ln_b_ + layer * 512 + 8 * lane), lb1 = *(const f32x4*)(conv_ln_b_ + layer * 512 + 8 * lane + 4);
#pragma unroll 1
    for (int qq = 0; qq < 4; ++qq) {
        const int o = 4 * wv + qq;
        f32x4 v0 = *(const LAS f32x4*)(CT + o * 512 + 8 * lane), v1 = *(const LAS f32x4*)(CT + o * 512 + 8 * lane + 4);
        const float mu = wave_sum((v0[0] + v0[1]) + (v0[2] + v0[3]) + (v1[0] + v1[1]) + (v1[2] + v1[3])) * (1.0f / 512.0f);
        v0 = v0 - mu; v1 = v1 - mu;
        const float var = wave_sum((v0[0] * v0[0] + v0[1] * v0[1]) + (v0[2] * v0[2] + v0[3] * v0[3]) + (v1[0] * v1[0] + v1[1] * v1[1]) + (v1[2] * v1[2] + v1[3] * v1[3])) * (1.0f / 512.0f);
        const float rstd = __builtin_amdgcn_rsqf(var + EPS);
        f32x4 y0 = v0 * rstd * lg0 + lb0, y1 = v1 * rstd * lg1 + lb1;
#pragma unroll
        for (int e = 0; e < 4; ++e) { y0[e] = y0[e] * __builtin_amdgcn_rcpf(1.f + __expf(-y0[e])); y1[e] = y1[e] * __builtin_amdgcn_rcpf(1.f + __expf(-y1[e])); }
        v4u ov; ov.x = pk2(y0[0], y0[1]); ov.y = pk2(y0[2], y0[3]); ov.z = pk2(y1[0], y1[1]); ov.w = pk2(y1[2], y1[3]);
        *(v4u*)(WSB(WS_MIXCAT) + (size_t)(t0 + o) * DM + 1536 + 8 * lane) = ov;
    }
}

__global__ void __launch_bounds__(NWAVES * 64, 2) fwd_kernel(Args args) {
    extern __shared__ __attribute__((aligned(16))) unsigned char lds[];
    Frame F;
    F.lds = (LAS unsigned char*)lds;
    F.G = gridDim.x; F.bx = blockIdx.x;
    const Args& A = args;
    unsigned char* ws = args.ws;
    volatile LAS unsigned* MISC = (volatile LAS unsigned*)(F.lds + MISC_OFF);
    if (threadIdx.x < 32) MISC[threadIdx.x] = 0u;
    __syncthreads();
    XcdBarrier bar = xcd_barrier_post((unsigned*)(ws + WS_CTL) + CW_BAR, MISC + 8);

    for (int rep = 0; rep < DUPN(0); ++rep) { if (PH(0)) p0a(F, A);
    xcd_barrier(bar); }
    for (int rp_ = 0; rp_ < DUPN(1); ++rp_) {
        const int fl = F.bx >> 5, fu = F.bx & 31;
        pg8::OneUnit S; S.has = F.bx < 128; S.pm = fu >> 2; S.pn = fu & 3;
        S.kt0 = (S.pn == 0) ? 0 : (S.pn == 1 ? 4 : 8); S.nt = (S.pn < 2) ? 4 : 8;
        const int fls = S.has ? fl : 0;
        pg8::Gemm g{WSB(WS_WOT2) + (size_t)fls * DM * 1024, WSB(WS_WBD) + (size_t)fls * 1024 * 1024, DM, 1024, 1024};
        pg8::EpiB<0, false> E{WSB(WS_WOUT) + (size_t)fls * DM * DM + 1024, DM, nullptr, nullptr, 0, nullptr, 0, 0, 0};
        if (PH(1)) pg8::gemm_phase<pg8::EpiB<0, false>, pg8::OneUnit, false, true>(F.lds, g, S, E);
        __syncthreads();
        const int gt = F.bx * (NWAVES * 64) + (int)threadIdx.x, NGT = F.G * NWAVES * 64;
        if (PH(2)) thin_phase<0, false>(F, A, nullptr, 0, 0, g_pre1_, DM, 0, 0, true);
    }
    xcd_barrier(bar);

    for (int l = 0; l < DEPTH; ++l) {
        for (int rep = 0; rep < DUPN(3); ++rep) {
            pg8::Gemm g{WSB(WS_H), WSB(WS_WIN) + (size_t)l * INW * DM, M, INW, DM}; pg8::P1Order S; S.c = F.bx; S.nt = DM / 64;
            pg8::EpiB<0, true> E{WSB(WS_Z), INW, A.out + OUT_NK, A.out + OUT_NV, l, WSB(WS_ZP), 1024, (size_t)MS * 1024, 2048, WSB(WS_QKV), M};
            if (PH(3)) pg8::gemm_phase<pg8::EpiB<0, true>, pg8::P1Order, true, true>(F.lds, g, S, E);
        xcd_barrier(bar);
        }
        for (int rep = 0; rep < DUPN(4); ++rep) {
            if (F.bx < 128) { if (PH(4)) { attn_unit<true>(F, A, l, F.bx); __syncthreads(); } if (PH(6)) { convpool_tile(F, A, l, F.bx); __syncthreads(); } }
            else { if (PH(5)) { attn_unit<false>(F, A, l, 2 * (F.bx - 128)); __syncthreads(); attn_unit<false>(F, A, l, 2 * (F.bx - 128) + 1); __syncthreads(); }
                   if (PH(6)) { convpool_tile(F, A, l, F.bx); __syncthreads(); convpool_tile(F, A, l, 128 + F.bx); __syncthreads(); } }
        xcd_barrier(bar);
        }
        for (int rep = 0; rep < DUPN(7); ++rep) {
            pg8::Gemm g{WSB(WS_MIXCAT), WSB(WS_WOUT) + (size_t)l * DM * DM, M, DM, DM}; pg8::SplitOrder S; S.c = F.bx; S.nt = DM / 64;
            pg8::EpiB<0, false> E{WSB(WS_MIX), DM, nullptr, nullptr, 0, WSB(WS_MIX2), DM, 0, 0};
            if (PH(7)) pg8::gemm_phase<pg8::EpiB<0, false>, pg8::SplitOrder, true, true>(F.lds, g, S, E);
            if (rep + 1 < DUPN(7)) xcd_barrier(bar);
        }
        thin_phase<1, false, 4>(F, A, g_post1_ + l * DM, 2 * DM, l, g_pre2_ + l * DM, 4 * DM, 3 * DM, l, l == 0, &bar);
        xcd_barrier(bar);
        for (int rep = 0; rep < DUPN(9); ++rep) {
            pg8::Gemm g{WSB(WS_H), WSB(WS_W1) + (size_t)l * DFF * DM, M, DFF, DM}; pg8::StaticOrder S; S.init(M, DFF, DM, F.G, F.bx);
            pg8::EpiB<1, false> E{WSB(WS_U), DFF, nullptr, nullptr, 0, nullptr, 0, 0, 0};
            if (PH(9)) pg8::gemm_phase<pg8::EpiB<1, false>, pg8::StaticOrder, true, true>(F.lds, g, S, E);
        xcd_barrier(bar);
        }
        for (int rep = 0; rep < DUPN(10); ++rep) {
            pg8::Gemm g{WSB(WS_U), WSB(WS_W2) + (size_t)l * DM * DFF, M, DM, DFF}; pg8::SplitOrder S; S.c = F.bx; S.nt = DFF / 64;
            pg8::EpiB<0, false> E{WSB(WS_MIX), DM, nullptr, nullptr, 0, WSB(WS_MIX2), DM, 0, 0};
            if (PH(10)) pg8::gemm_phase<pg8::EpiB<0, false>, pg8::SplitOrder, true, true>(F.lds, g, S, E);
            if (rep + 1 < DUPN(10)) xcd_barrier(bar);
        }
        if (l + 1 < DEPTH) { thin_phase<1, false, 4>(F, A, g_post2_ + l * DM, 5 * DM, l, g_pre1_ + (l + 1) * DM, DM, 0, l + 1, false, &bar); xcd_barrier(bar); }
        else thin_phase<2, false, 4>(F, A, g_post2_ + l * DM, 5 * DM, l, nullptr, 0, 0, l, false, &bar);
    }
}

extern "C" void kernel_launch(void* const* d_in, const int* in_sizes, int n_in, void* d_out, int out_size, void* d_ws, size_t ws_size, hipStream_t stream) {
    static int grid = 0;
    if (grid == 0) {
        if (n_in != 24 || ws_size < WS_END) { fprintf(stderr, "kernel_launch: bad arguments (n_in %d, ws %zu)\n", n_in, ws_size); grid = -1; return; }
        int dev = 0, cus = 0, per_cu = 0;
        if (hipGetDevice(&dev) != hipSuccess || hipDeviceGetAttribute(&cus, hipDeviceAttributeMultiprocessorCount, dev) != hipSuccess) { grid = -1; return; }
        if (hipFuncSetAttribute((const void*)fwd_kernel, hipFuncAttributeMaxDynamicSharedMemorySize, LDS_BYTES) != hipSuccess) { fprintf(stderr, "kernel_launch: hipFuncSetAttribute failed\n"); grid = -1; return; }
        if (hipOccupancyMaxActiveBlocksPerMultiprocessor(&per_cu, (const void*)fwd_kernel, NWAVES * 64, LDS_BYTES) != hipSuccess || per_cu < 1) { fprintf(stderr, "kernel_launch: occupancy query says %d\n", per_cu); per_cu = 1; }
        (void)hipGetLastError();
        if (cus < 256) { fprintf(stderr, "kernel_launch: needs 256 CUs, found %d\n", cus); grid = -1; return; }
        grid = 256;
    }
    if (grid < 0) return;
    (void)in_sizes; (void)out_size;
    if (hipMemsetAsync((char*)d_ws + WS_CTL, 0, CTL_ZERO_BYTES, stream) != hipSuccess) return;
    Args a{};
    for (int i = 0; i < 24; ++i) a.in[i] = (const float*)d_in[i];
    a.out = (float*)d_out; a.ws = (unsigned char*)d_ws;
    hipLaunchKernelGGL(fwd_kernel, dim3(grid), dim3(NWAVES * 64), LDS_BYTES, stream, a);
}
```

```cpp
#include <hip/hip_runtime.h>
#include <cstdio>
#include <cstdint>

namespace pg8 {
#define PG8_LAS __attribute__((address_space(3)))
typedef unsigned short bf16_t;
typedef short bf16x8 __attribute__((ext_vector_type(8)));
typedef float f32x4 __attribute__((ext_vector_type(4)));
typedef unsigned u32x4 __attribute__((ext_vector_type(4)));
constexpr int BM = 256, BK = 64, HALF = 128, HTB = HALF * BK * 2  , STAGE_BYTES = 8 * HTB, NXCD = 8, WGM = 8;

__host__ __device__ __forceinline__ int lds_byte(int r, int c) { const int st = (r >> 4) * 2 + (c >> 5), rr = r & 15, cc = c & 31, ob = rr * 64 + cc * 2; return st * 1024 + (ob ^ (((ob >> 9) & 1) << 5)); }
__host__ __device__ __forceinline__ void stage_rc(int b, int& R, int& C) { const int st = b / 1024, sb = b % 1024, swz = sb ^ (((sb >> 9) & 1) << 5); R = (st >> 1) * 16 + swz / 64; C = (st & 1) * 32 + (swz % 64) / 2; }
__host__ __device__ __forceinline__ int perm32(int rho) { const int n = rho >> 4, i = rho & 15; return 8 * (i >> 2) + 4 * n + (i & 3); }

struct Unit { int pm, pn, kt0, ktn, part; };
struct Gemm { const bf16_t* A; const bf16_t* Bt; int M, N, K; };

struct StaticOrder {
    int nM, nN, nwg, G, c, nt;
    __host__ __device__ void init(int M, int N, int K, int G_, int c_) { nM = M / BM; nN = N / BM; nwg = nM * nN; G = G_; c = c_; nt = K / BK; }
    __host__ __device__ bool next(int i, Unit& u) const {
        const long L = (long)i * G + c; if (L >= nwg) return false;
        int wgid = (int)L; { const int q = nwg / NXCD, r = nwg % NXCD, xcd = wgid % NXCD, off = wgid / NXCD; wgid = (xcd < r ? xcd * (q + 1) : r * (q + 1) + (xcd - r) * q) + off; }
        const int nig = WGM * nN, gid = wgid / nig, fm = gid * WGM, gsz = (nM - fm) < WGM ? (nM - fm) : WGM;
        u.pm = fm + ((wgid % nig) % gsz); u.pn = (wgid % nig) / gsz; u.kt0 = 0; u.ktn = nt; u.part = 0; return true;
    }
    __device__ __forceinline__ void a_ready(const Unit&) const {}
    __device__ __forceinline__ void done(const Unit&) const {}
};
struct OneUnit {
    int pm, pn, kt0, nt; bool has;
    __device__ bool next(int i, Unit& u) const { if (i != 0 || !has) return false; u.pm = pm; u.pn = pn; u.kt0 = kt0; u.ktn = nt; u.part = 0; return true; }
    __device__ __forceinline__ void a_ready(const Unit&) const {}
    __device__ __forceinline__ void done(const Unit&) const {}
};

struct SplitOrder {
    int c, nt;
    __device__ bool next(int i, Unit& u) const {
        if (i > 1) return false;
        const int w = (c & 7) * 32 + (c >> 3);
        if (i == 0) { u.pm = w >> 3; u.pn = w & 7; u.kt0 = 0; u.ktn = nt; u.part = 0; }
        else { const int kh = w >> 7, t = w & 127; u.pm = 32 + (t >> 3); u.pn = t & 7; u.kt0 = kh * (nt >> 1); u.ktn = nt >> 1; u.part = kh; }
        return true;
    }
    __device__ __forceinline__ void a_ready(const Unit&) const {}
    __device__ __forceinline__ void done(const Unit&) const {}
};
struct P1Order {
    int c, nt;
    __device__ bool next(int i, Unit& u) const {
        if (i > 2) return false;
        if (i < 2) { const int L = i * 256 + c; const int wgid = (L & 7) * 64 + (L >> 3);
            if (wgid < 384) { const int gid = wgid / 96, rr = wgid % 96; u.pm = 8 * gid + (rr & 7); u.pn = rr >> 3; }
            else { const int w2 = wgid - 384, gid = w2 >> 6, rr = w2 & 63; u.pm = 32 + 8 * gid + (rr & 7); u.pn = rr >> 3; }
            u.kt0 = 0; u.ktn = nt; u.part = 0; }
        else { const int x = c & 7, j = c >> 3, kq = x & 3;
            u.pm = 32 + 8 * (x >> 2) + (j & 7); u.pn = 8 + (j >> 3); u.kt0 = kq * (nt >> 2); u.ktn = nt >> 2; u.part = 1 + kq; }
        return true;
    }
    __device__ __forceinline__ void a_ready(const Unit&) const {}
    __device__ __forceinline__ void done(const Unit&) const {}
};
typedef float f32x2_t __attribute__((ext_vector_type(2))); typedef __bf16 bf16x2_t __attribute__((ext_vector_type(2)));
__device__ __forceinline__ unsigned cvt_pk_bf16(float lo, float hi) { f32x2_t v = {lo, hi}; bf16x2_t b = __builtin_convertvector(v, bf16x2_t); return __builtin_bit_cast(unsigned, b); }

struct EpiF32 {
    static constexpr bool PERM = false, AFTER_DRAIN = false;
    float* C; float* C1; int ldc;
    __device__ __forceinline__ void operator()(const f32x4 (&acc)[2][2][4][2], const Unit& u, int wr, int wc, int fr, int fq) const {
        const int row0 = (u.part ? (u.pm - 32) : u.pm) * BM + wr * 64 + fr, col0 = u.pn * BM + wc * 32 + 4 * fq;
        float* base = u.part ? C1 : C;
#pragma unroll
        for (int ai = 0; ai < 2; ++ai)
#pragma unroll
            for (int m = 0; m < 4; ++m) { float* rowp = base + (size_t)(row0 + ai * HALF + m * 16) * ldc + col0;
#pragma unroll
                for (int bj = 0; bj < 2; ++bj)
#pragma unroll
                    for (int n = 0; n < 2; ++n) *(f32x4*)(rowp + bj * HALF + n * 16) = acc[ai][bj][m][n]; }
    }
};
template <int ACT, bool KV> struct EpiB {
    static constexpr bool PERM = true, AFTER_DRAIN = false;
    bf16_t* O; int ldc; float* nk; float* nv; int layer;
    bf16_t* O1; int ldc1; size_t pstride; int pcol0;
    __device__ __forceinline__ void operator()(const f32x4 (&acc)[2][2][4][2], const Unit& u, int wr, int wc, int fr, int fq) const {
        const int rloc = wr * 64 + fr, row0 = (u.part ? (u.pm - 32) : u.pm) * BM + rloc, cloc = wc * 32 + 8 * fq, col0 = u.pn * BM + cloc - (u.part ? pcol0 : 0);
        bf16_t* base = u.part ? O1 + (size_t)(u.part - 1) * pstride : O; const int ld = u.part ? ldc1 : ldc;
        float* kvp = nullptr;
        if (KV) { if (u.pm < 32 && (u.pn == 4 || u.pn == 5)) kvp = (u.pn == 4 ? nk : nv) + ((size_t)(u.pm * 4 + layer) * 256 + rloc) * 256 + cloc; }
#pragma unroll
        for (int ai = 0; ai < 2; ++ai)
#pragma unroll
            for (int m = 0; m < 4; ++m) { bf16_t* rowp = base + (size_t)(row0 + ai * HALF + m * 16) * ld + col0;
#pragma unroll
                for (int bj = 0; bj < 2; ++bj) { f32x4 v0 = acc[ai][bj][m][0], v1 = acc[ai][bj][m][1];
                    if (ACT == 1) {
#pragma unroll
                        for (int j = 0; j < 4; ++j) { const float a = fmaxf(v0[j], 0.f), b = fmaxf(v1[j], 0.f); v0[j] = a * a; v1[j] = b * b; } }
                    u32x4 w; w.x = cvt_pk_bf16(v0[0], v0[1]); w.y = cvt_pk_bf16(v0[2], v0[3]); w.z = cvt_pk_bf16(v1[0], v1[1]); w.w = cvt_pk_bf16(v1[2], v1[3]);
                    *(u32x4*)(rowp + bj * HALF) = w;
                    if (KV) { if (kvp) { float* p = kvp + (size_t)(ai * HALF + m * 16) * 256 + bj * HALF; *(f32x4*)p = v0; *(f32x4*)(p + 4) = v1; } }
                } }
    }
};

template <class Epi, class Sched, bool ALIGN_EPI = false, bool SP2 = false>
__device__ __forceinline__ void gemm_phase(PG8_LAS unsigned char* lds, const Gemm g, const Sched& S, const Epi& E) {
    int tid_ = threadIdx.x; asm volatile("" : "+v"(tid_));
    const int tid = tid_, wid = __builtin_amdgcn_readfirstlane(tid >> 6), lane = tid & 63, wr = wid >> 2, wc = wid & 3, fr = lane & 15, fq = lane >> 4;
    const int K = g.K;
    unsigned voffA[2], voffB[2];
#pragma unroll
    for (int i = 0; i < 2; ++i) { int R, C; stage_rc(tid * 16 + i * 8192, R, C); const int Rb = Epi::PERM ? ((R & ~31) + perm32(R & 31)) : R;
        voffA[i] = (unsigned)(R * K + C) * 2u; voffB[i] = (unsigned)(Rb * K + C) * 2u; }
    const size_t kstep = (size_t)(BK * 2);
    const size_t hstep = (size_t)HALF * K * 2;
    const size_t tstep = 2 * hstep;
    const unsigned ldsw = (unsigned)wid * 1024u;
    const int aoff = lds_byte(wr * 64 + fr, fq * 8), boff = lds_byte(wc * 32 + fr, fq * 8);
#define PG8_SA(b, h) (((b) * 2 + (h)) * HTB)
#define PG8_SB(b, h) ((4 + (b) * 2 + (h)) * HTB)
#define PG8_STAGE(bufoff, gbase, voff) do { _Pragma("unroll") for (int _i = 0; _i < 2; ++_i) \
        __builtin_amdgcn_global_load_lds((const unsigned*)((const char*)(gbase) + (voff)[_i]), (PG8_LAS unsigned*)(lds + (bufoff) + ldsw + _i * 8192), 16, 0, 0); } while (0)
#define PG8_LDA(dst, b, h) do { _Pragma("unroll") for (int m = 0; m < 4; ++m) _Pragma("unroll") for (int k = 0; k < 2; ++k) dst[m][k] = *(const PG8_LAS bf16x8*)(lds + PG8_SA(b, h) + aoff + m * 2048 + k * 1024); } while (0)
#define PG8_LDB(dst, b, h) do { _Pragma("unroll") for (int n = 0; n < 2; ++n) _Pragma("unroll") for (int k = 0; k < 2; ++k) dst[n][k] = *(const PG8_LAS bf16x8*)(lds + PG8_SB(b, h) + boff + n * 2048 + k * 1024); } while (0)
#define PG8_MMA(ai, bj, At, Bt) do { __builtin_amdgcn_s_setprio(1); _Pragma("unroll") for (int m = 0; m < 4; ++m) _Pragma("unroll") for (int n = 0; n < 2; ++n) _Pragma("unroll") for (int k = 0; k < 2; ++k) \
        acc[ai][bj][m][n] = __builtin_amdgcn_mfma_f32_16x16x32_bf16(Bt[n][k], At[m][k], acc[ai][bj][m][n], 0, 0, 0); __builtin_amdgcn_s_setprio(0); } while (0)
#define PG8_WAIT_V(n) asm volatile("s_waitcnt vmcnt(" #n ")" ::: "memory")
#define PG8_WAIT_L(n) asm volatile("s_waitcnt lgkmcnt(" #n ")" ::: "memory")
#define PG8_BAR __builtin_amdgcn_s_barrier()
#define PG8_SCHED __builtin_amdgcn_sched_barrier(0)
    Unit cur, nxt; int ui = 0;
    if (!S.next(0, cur)) return;
    f32x4 acc[2][2][4][2];
#pragma unroll
    for (int a = 0; a < 2; ++a)
#pragma unroll
        for (int b = 0; b < 2; ++b)
#pragma unroll
            for (int m = 0; m < 4; ++m)
#pragma unroll
                for (int n = 0; n < 2; ++n) acc[a][b][m][n] = (f32x4){0.f, 0.f, 0.f, 0.f};
    bf16x8 At[4][2], B0[2][2], B1[2][2];
    const char* cA = (const char*)g.A + (size_t)cur.pm * tstep + (size_t)cur.kt0 * kstep; const char* cB = (const char*)g.Bt + (size_t)cur.pn * tstep + (size_t)cur.kt0 * kstep;
    S.a_ready(cur);
    if constexpr (SP2) {
        PG8_STAGE(PG8_SB(0, 0), cB, voffB); PG8_STAGE(PG8_SB(0, 1), cB + hstep, voffB); PG8_STAGE(PG8_SA(0, 0), cA, voffA); PG8_STAGE(PG8_SA(0, 1), cA + hstep, voffA);
        if (wr == 1) PG8_BAR;
        PG8_WAIT_V(2); PG8_BAR;
        PG8_STAGE(PG8_SB(1, 0), cB + kstep, voffB); PG8_STAGE(PG8_SA(1, 0), cA + kstep, voffA); PG8_STAGE(PG8_SB(1, 1), cB + hstep + kstep, voffB);
        PG8_WAIT_V(6); PG8_BAR;
    } else {
        PG8_STAGE(PG8_SB(0, 0), cB, voffB); PG8_STAGE(PG8_SA(0, 0), cA, voffA); PG8_STAGE(PG8_SB(0, 1), cB + hstep, voffB); PG8_STAGE(PG8_SA(0, 1), cA + hstep, voffA);
        if (wr == 1) PG8_BAR;
        PG8_WAIT_V(4); PG8_BAR;
        PG8_STAGE(PG8_SB(1, 0), cB + kstep, voffB); PG8_STAGE(PG8_SA(1, 0), cA + kstep, voffA); PG8_STAGE(PG8_SB(1, 1), cB + hstep + kstep, voffB);
        PG8_WAIT_V(6); PG8_BAR;
    }
    for (;;) {
        const bool has_next = S.next(ui + 1, nxt);
        const char* nA = has_next ? (const char*)g.A + (size_t)nxt.pm * tstep + (size_t)nxt.kt0 * kstep : cA; const char* nB = has_next ? (const char*)g.Bt + (size_t)nxt.pn * tstep + (size_t)nxt.kt0 * kstep : cB;
        const int nt = cur.ktn;
        for (int t = 0; t < nt; t += 2) {
            const bool last = (t == nt - 2);
            const char* a1 = cA + (size_t)(t + 1) * kstep;
            const char* a2 = last ? nA : cA + (size_t)(t + 2) * kstep; const char* b2 = last ? nB : cB + (size_t)(t + 2) * kstep;
            const char* a3 = a2 + kstep; const char* b3 = b2 + kstep;
            if (last && has_next) S.a_ready(nxt);
            if constexpr (SP2) {
            PG8_STAGE(PG8_SA(1, 1), a1 + hstep, voffA); PG8_SCHED; PG8_LDB(B0, 0, 0); PG8_LDB(B1, 0, 1); PG8_SCHED; PG8_LDA(At, 0, 0);
            PG8_WAIT_V(8); PG8_WAIT_L(0); PG8_BAR; PG8_MMA(0, 0, At, B0); PG8_MMA(0, 1, At, B1); PG8_BAR; PG8_SCHED;
            PG8_STAGE(PG8_SB(0, 0), b2, voffB); PG8_STAGE(PG8_SB(0, 1), b2 + hstep, voffB); PG8_STAGE(PG8_SA(0, 0), a2, voffA); PG8_SCHED; PG8_LDA(At, 0, 1);
            PG8_WAIT_V(8); PG8_WAIT_L(0); PG8_BAR; PG8_MMA(1, 0, At, B0); PG8_MMA(1, 1, At, B1); PG8_BAR; PG8_SCHED;
            PG8_STAGE(PG8_SA(0, 1), a2 + hstep, voffA); PG8_SCHED; PG8_LDB(B0, 1, 0); PG8_LDB(B1, 1, 1); PG8_SCHED; PG8_LDA(At, 1, 0);
            PG8_WAIT_V(8); PG8_WAIT_L(0); PG8_BAR; PG8_MMA(0, 0, At, B0); PG8_MMA(0, 1, At, B1); PG8_BAR; PG8_SCHED;
            PG8_STAGE(PG8_SB(1, 0), b3, voffB); PG8_STAGE(PG8_SB(1, 1), b3 + hstep, voffB); PG8_STAGE(PG8_SA(1, 0), a3, voffA); PG8_SCHED; PG8_LDA(At, 1, 1);
            PG8_WAIT_V(8); PG8_WAIT_L(0); PG8_BAR; PG8_MMA(1, 0, At, B0); PG8_MMA(1, 1, At, B1); PG8_BAR; PG8_SCHED;
            } else {
            PG8_LDB(B0, 0, 0); PG8_SCHED; PG8_LDA(At, 0, 0); PG8_STAGE(PG8_SA(1, 1), a1 + hstep, voffA);
            PG8_WAIT_L(8); PG8_BAR; PG8_WAIT_L(0); PG8_MMA(0, 0, At, B0); PG8_BAR; PG8_SCHED;
            PG8_LDB(B1, 0, 1); PG8_STAGE(PG8_SB(0, 0), b2, voffB);
            PG8_BAR; PG8_WAIT_L(0); PG8_MMA(0, 1, At, B1); PG8_BAR;
            PG8_LDA(At, 0, 1); PG8_STAGE(PG8_SA(0, 0), a2, voffA);
            PG8_BAR; PG8_WAIT_L(0); PG8_MMA(1, 0, At, B0); PG8_BAR; PG8_SCHED;
            PG8_STAGE(PG8_SB(0, 1), b2 + hstep, voffB);
            PG8_WAIT_V(6); PG8_BAR; PG8_MMA(1, 1, At, B1); PG8_BAR;
            PG8_LDB(B0, 1, 0); PG8_SCHED; PG8_LDA(At, 1, 0); PG8_STAGE(PG8_SA(0, 1), a2 + hstep, voffA);
            PG8_WAIT_L(8); PG8_BAR; PG8_WAIT_L(0); PG8_MMA(0, 0, At, B0); PG8_BAR; PG8_SCHED;
            PG8_LDB(B1, 1, 1); PG8_STAGE(PG8_SB(1, 0), b3, voffB);
            PG8_BAR; PG8_WAIT_L(0); PG8_MMA(0, 1, At, B1); PG8_BAR;
            PG8_LDA(At, 1, 1); PG8_STAGE(PG8_SA(1, 0), a3, voffA);
            PG8_BAR; PG8_WAIT_L(0); PG8_MMA(1, 0, At, B0); PG8_BAR; PG8_SCHED;
            PG8_STAGE(PG8_SB(1, 1), b3 + hstep, voffB);
            PG8_WAIT_V(6); PG8_BAR; PG8_MMA(1, 1, At, B1); PG8_BAR;
            }
        }
        if constexpr (ALIGN_EPI) { if (wr == 0) PG8_BAR; }
        if constexpr (!Epi::AFTER_DRAIN) { E(acc, cur, wr, wc, fr, fq); S.done(cur); }
        if (!has_next) break;
#pragma unroll
        for (int a = 0; a < 2; ++a)
#pragma unroll
            for (int b = 0; b < 2; ++b)
#pragma unroll
                for (int m = 0; m < 4; ++m)
#pragma unroll
                    for (int n = 0; n < 2; ++n) acc[a][b][m][n] = (f32x4){0.f, 0.f, 0.f, 0.f};
        cur = nxt; cA = nA; cB = nB; ++ui;
        if constexpr (ALIGN_EPI) { if (wr == 1) PG8_BAR; }
    }
    PG8_WAIT_V(0);
    if constexpr (!ALIGN_EPI) { if (wr == 0) PG8_BAR; }
    PG8_BAR;
#undef PG8_SA
#undef PG8_SB
#undef PG8_STAGE
#undef PG8_LDA
#undef PG8_LDB
#undef PG8_MMA
#undef PG8_WAIT_V
#undef PG8_WAIT_L
#undef PG8_BAR
#undef PG8_SCHED
}
}

#ifndef PHASE_MASK
#define PHASE_MASK 0xFFFF
#endif
#define PH(k) ((PHASE_MASK >> (k)) & 1)
#ifndef DUP_MASK
#define DUP_MASK 0
#endif
#define DUPN(k) (1 + ((DUP_MASK >> (k)) & 1))
constexpr int NWAVES = 8;
constexpr int DM = 2048, NB_P = 32, SEQ_P = 256, DEPTH = 4, NB_S = 2, SEQ_S = 2048, PAST = 512;
constexpr int MP = NB_P * SEQ_P, MS = NB_S * SEQ_S, M = MP + MS;
constexpr int INW = 3072, DFF = 8192, HD = 64;
constexpr int OK_ = 1024, OV_ = 1280, OPU = 1536, OCA = 2048, OCG = 2560;
constexpr int ADA = 6 * DM;
constexpr float EPS = 1e-6f;
constexpr float LOG2E = 1.4426950408889634f;
constexpr size_t OUT_Y = 0, OUT_NK = (size_t)M * DM, OUT_NV = OUT_NK + (size_t)NB_P * DEPTH * SEQ_P * 256;

constexpr size_t MiB = 1u << 20;
constexpr size_t WS_CTL = 0, CTL_ZERO_BYTES = 1 * MiB;
constexpr size_t WS_MODS = 1 * MiB;
constexpr size_t WS_ROPE = 2 * MiB;
constexpr size_t WS_MODP = 3 * MiB;
constexpr size_t WS_KC = 8 * MiB;
constexpr size_t WS_VC = 10 * MiB;
constexpr size_t WS_WBD = 12 * MiB;
constexpr size_t WS_WOT2 = 20 * MiB;
constexpr size_t WS_WIN = 36 * MiB;
constexpr size_t WS_WOUT = 84 * MiB;
constexpr size_t WS_W1 = 116 * MiB;
constexpr size_t WS_W2 = 244 * MiB;
constexpr size_t WS_H = 372 * MiB;
constexpr size_t WS_Z = 420 * MiB;
constexpr size_t WS_MIXCAT = 492 * MiB;
constexpr size_t WS_MIX = 540 * MiB;
constexpr size_t WS_U = 636 * MiB;
constexpr size_t WS_MIX2 = 828 * MiB;
constexpr size_t WS_ZP = 844 * MiB;
constexpr size_t WS_XB = 876 * MiB;
constexpr size_t WS_END = 924 * MiB;
constexpr int CW_BAR = 4096, CW_GEMV = 1024;

constexpr int LDS_BYTES = 147456;
constexpr int MISC_OFF = 135168;

#define GAS __attribute__((address_space(1)))
#define LAS __attribute__((address_space(3)))
typedef unsigned short bf16;
typedef unsigned v4u __attribute__((ext_vector_type(4)));
typedef unsigned v2u __attribute__((ext_vector_type(2)));
typedef float f32x4 __attribute__((ext_vector_type(4)));
typedef float f32x16 __attribute__((ext_vector_type(16)));
typedef short bf16x8 __attribute__((ext_vector_type(8)));
typedef short s16x4 __attribute__((ext_vector_type(4)));
#define LDS_WAIT() asm volatile("s_waitcnt lgkmcnt(0)" ::: "memory")
#define VM_WAIT() asm volatile("s_waitcnt vmcnt(0)" ::: "memory")
__device__ __forceinline__ unsigned pk2(float lo, float hi) { return pg8::cvt_pk_bf16(lo, hi); }
__device__ __forceinline__ float bf2f(bf16 b) { return __uint_as_float((unsigned)b << 16); }
__device__ __forceinline__ float bflo(unsigned w) { return __uint_as_float(w << 16); }
__device__ __forceinline__ float bfhi(unsigned w) { return __uint_as_float(w & 0xffff0000u); }

#define XB_TMO      128
#define XB_XCNT(j)  (256  + 64 * (j))
#define XB_XSUB(j)  (1280 + 64 * (j))
#define XB_XGEN(j)  (2304 + 64 * (j))
#define XB_TOP      3328
#define XB_TOPGEN   3392
#define XCD_BAR_WORDS 3456
#define XB_SPIN_CAP (1u << 18)
__device__ __forceinline__ unsigned xb_ld(unsigned* p)              { return __hip_atomic_load(p, __ATOMIC_RELAXED, __HIP_MEMORY_SCOPE_AGENT); }
__device__ __forceinline__ unsigned xb_add(unsigned* p, unsigned v) { return __hip_atomic_fetch_add(p, v, __ATOMIC_RELAXED, __HIP_MEMORY_SCOPE_AGENT); }
__device__ __forceinline__ unsigned xb_xcc_id() { return (unsigned)__builtin_amdgcn_s_getreg((3 << 11) | 20) & 0xFu; }
#define XB_SPIN(cond, bar) do { unsigned _sp = 0; while (cond) { __builtin_amdgcn_s_sleep(1); \
    if ((++_sp & 255u) == 0u) { if (xb_ld(&(bar)[XB_TMO])) break; if (_sp > XB_SPIN_CAP) { atomicAdd(&(bar)[XB_TMO], 1u); break; } } } } while (0)
struct XcdBarrier { unsigned* bar; unsigned x; volatile LAS unsigned* st; };
__device__ __forceinline__ XcdBarrier xcd_barrier_post(unsigned* bar, volatile LAS unsigned* st) {
    XcdBarrier b; b.bar = bar; b.x = xb_xcc_id(); b.st = st;
    if (threadIdx.x == 0) (void)xb_add(&bar[XB_XCNT(b.x)], 1u);
    return b;
}
__device__ __forceinline__ void xcd_barrier_complete(unsigned* bar, unsigned x, unsigned& nloc, unsigned& nx) {
    const unsigned G = gridDim.x * gridDim.y * gridDim.z;
    unsigned sum, cnt, mine, sp = 0u;
    for (;;) {
        sum = 0u; cnt = 0u; mine = 0u;
#pragma unroll
        for (unsigned j = 0; j < 16; ++j) { const unsigned c = xb_ld(&bar[XB_XCNT(j)]); sum += c; cnt += (c > 0u) ? 1u : 0u; mine = (j == x) ? c : mine; }
        if (sum == G) break;
        __builtin_amdgcn_s_sleep(1);
        if ((++sp & 255u) == 0u) { if (xb_ld(&bar[XB_TMO])) break; if (sp > XB_SPIN_CAP) { atomicAdd(&bar[XB_TMO], 1u); break; } }
    }
    nloc = mine > 0u ? mine : 1u; nx = cnt > 0u ? cnt : 1u;
}
__device__ __forceinline__ void xcd_barrier_leader(const XcdBarrier& b) {
    {
        unsigned* bar = b.bar;
        __builtin_amdgcn_s_waitcnt(0);
        unsigned nloc = b.st[0], nx = b.st[1];
        if (nloc == 0u) { xcd_barrier_complete(bar, b.x, nloc, nx); b.st[0] = nloc; b.st[1] = nx; }
        const unsigned old = xb_add(&bar[XB_XSUB(b.x)], 1u);
        const unsigned gen = old / nloc;
        if (old + 1u == (gen + 1u) * nloc) {
            __builtin_amdgcn_fence(__ATOMIC_RELEASE, "agent");
            asm volatile("s_waitcnt vmcnt(0)" ::: "memory");
            const unsigned og = xb_add(&bar[XB_TOP], 1u);
            const unsigned tg = og / nx;
            if (og + 1u == (tg + 1u) * nx) xb_add(&bar[XB_TOPGEN], 1u);
            else XB_SPIN(xb_ld(&bar[XB_TOPGEN]) == tg, bar);
            __builtin_amdgcn_fence(__ATOMIC_ACQUIRE, "agent");
            xb_add(&bar[XB_XGEN(b.x)], 1u);
            asm volatile("s_waitcnt vmcnt(0)" ::: "memory");
        } else {
            XB_SPIN(xb_ld(&bar[XB_XGEN(b.x)]) == gen, bar);
            __builtin_amdgcn_fence(__ATOMIC_ACQUIRE, "agent");
            asm volatile("s_waitcnt vmcnt(0)" ::: "memory");
        }
    }
}
__device__ __forceinline__ void xcd_barrier(const XcdBarrier& b) {
    asm volatile("s_waitcnt vmcnt(0)" ::: "memory");
    __syncthreads();
    if (threadIdx.x == 0) xcd_barrier_leader(b);
    __syncthreads();
}

struct Args { const float* in[24]; float* out; unsigned char* ws; };
struct Frame {
    LAS unsigned char* lds;
    int G, bx;
};
#define IN_(k) (A.in[k])
#define x_prompt_ IN_(0)
#define x_sample_ IN_(1)
#define cache_k_ IN_(2)
#define cache_v_ IN_(3)
#define c_ IN_(4)
#define c_ctx_ IN_(5)
#define w_ada_ IN_(6)
#define b_ada_ IN_(7)
#define g_pre1_ IN_(8)
#define g_post1_ IN_(9)
#define g_pre2_ IN_(10)
#define g_post2_ IN_(11)
#define w_in_ IN_(12)
#define sink_ IN_(13)
#define w_pool_ IN_(14)
#define pool_scale_ IN_(15)
#define conv_dw_ IN_(16)
#define conv_b_ IN_(17)
#define conv_ln_g_ IN_(18)
#define conv_ln_b_ IN_(19)
#define w_conv_pw_ IN_(20)
#define w_out_ IN_(21)
#define w_mlp1_ IN_(22)
#define w_mlp2_ IN_(23)
#define WSF(off) ((float*)(A.ws + (off)))
#define WSB(off) ((bf16*)(A.ws + (off)))
#define PHASE_IDS() int tid_ = threadIdx.x; asm volatile("" : "+v"(tid_)); const int tid = tid_, lane = tid & 63, wv = __builtin_amdgcn_readfirstlane(tid >> 6); (void)lane; (void)wv
#define DPP_F(old_, v_, ctrl_, rm_) __builtin_bit_cast(float, __builtin_amdgcn_update_dpp(__builtin_bit_cast(int, (float)(old_)), __builtin_bit_cast(int, (float)(v_)), (ctrl_), (rm_), 0xf, false))
__device__ __forceinline__ float wave_sum(float v) {
    v += DPP_F(0.f, v, 0xB1, 0xf);
    v += DPP_F(0.f, v, 0x4E, 0xf);
    v += DPP_F(0.f, v, 0x124, 0xf);
    v += DPP_F(0.f, v, 0x128, 0xf);
    v += DPP_F(0.f, v, 0x142, 0xa);
    v += DPP_F(0.f, v, 0x143, 0xc);
    return __builtin_bit_cast(float, __builtin_amdgcn_readlane(__builtin_bit_cast(int, v), 63));
}

__device__ __forceinline__ void tr_tile(const float* W, int N, bf16* WT, int ldt, int k0, int n0, LAS float* scr, int lane) {
    const int kq = lane >> 4, n4 = (lane & 15) * 4;
#pragma unroll 4
    for (int i = 0; i < 16; ++i) { const int kk = 4 * i + kq; const f32x4 v = *(const f32x4*)(W + (size_t)(k0 + kk) * N + n0 + n4);
        LAS float* d = scr + kk * 65 + n4; d[0] = v[0]; d[1] = v[1]; d[2] = v[2]; d[3] = v[3]; }
    LDS_WAIT(); asm volatile("" ::: "memory");
    const int c = lane & 7;
#pragma unroll
    for (int j = 0; j < 8; ++j) { const int n = (lane >> 3) + 8 * j; const LAS float* s = scr + (8 * c) * 65 + n;
        v4u o; o.x = pk2(s[0 * 65], s[1 * 65]); o.y = pk2(s[2 * 65], s[3 * 65]); o.z = pk2(s[4 * 65], s[5 * 65]); o.w = pk2(s[6 * 65], s[7 * 65]);
        *(v4u*)(WT + (size_t)(n0 + n) * ldt + k0 + 8 * c) = o; }
    LDS_WAIT(); asm volatile("" ::: "memory");
}
__device__ __forceinline__ void p0a(Frame& F, const Args& A) {
    PHASE_IDS();
    {
        LAS float* S = (LAS float*)F.lds;
        LAS float* RED = (LAS float*)(F.lds + 24576);
        for (int i = tid; i < 3 * DM; i += NWAVES * 64) { const int cv = i / DM, k = i % DM; const float v = (cv == 0) ? c_ctx_[k] : c_[(cv - 1) * DM + k]; S[i] = v / (1.f + expf(-v)); }
        __syncthreads();
        for (int rp_ = 0; rp_ < DUPN(14); ++rp_) for (int it = F.bx; it < DEPTH * 48 * 8; it += F.G) {
            const int l = it / 384, rem = it % 384, cc = rem >> 3, kp = rem & 7;
            const int kb = kp * 256 + wv * 32;
            const float* W = w_ada_ + ((size_t)l * DM + kb) * ADA + cc * 256 + lane * 4;
            f32x4 a0 = {0.f, 0.f, 0.f, 0.f}, a1 = a0, a2 = a0;
#pragma unroll 8
            for (int r = 0; r < 32; ++r) { const f32x4 w = *(const f32x4*)(W + (size_t)r * ADA); const float s0 = S[kb + r], s1 = S[DM + kb + r], s2 = S[2 * DM + kb + r];
                a0 += w * s0; a1 += w * s1; a2 += w * s2; }
            *(LAS f32x4*)(RED + (wv * 3 + 0) * 256 + lane * 4) = a0; *(LAS f32x4*)(RED + (wv * 3 + 1) * 256 + lane * 4) = a1; *(LAS f32x4*)(RED + (wv * 3 + 2) * 256 + lane * 4) = a2;
            __syncthreads();
            for (int o = tid; o < 768; o += NWAVES * 64) { const int cv = o >> 8, col = o & 255; float s = 0.f;
#pragma unroll
                for (int w8 = 0; w8 < 8; ++w8) s += RED[(w8 * 3 + cv) * 256 + col];
                WSF(WS_MODP)[((size_t)(kp * DEPTH + l) * 3 + cv) * ADA + cc * 256 + col] = s; }
            __syncthreads();
        }
    }
    asm volatile("s_waitcnt vmcnt(0)" ::: "memory");
    __syncthreads();
    if (tid == 0) { __builtin_amdgcn_fence(__ATOMIC_RELEASE, "agent"); (void)xb_add((unsigned*)(A.ws + WS_CTL) + CW_GEMV, 1u); }
    {
        LAS float* scr = (LAS float*)(F.lds + wv * 16640);
        const int gw = F.bx * NWAVES + wv, NGW = F.G * NWAVES;
        constexpr int T_IN = 32 * 48, T_OUT = 32 * 32, T_1 = 32 * 128, T_2 = 128 * 32, T_L = T_IN + T_OUT + T_1 + T_2;
#define TR_DEC(r_, nnb_, kb_, nb_) do { const int blk_ = (r_) >> 3, in_ = (r_) & 7, bn_ = blk_ % ((nnb_) / 4), bk_ = blk_ / ((nnb_) / 4); kb_ = 2 * bk_ + (in_ >> 2); nb_ = 4 * bn_ + (in_ & 3); } while (0)
        for (int rp_ = 0; rp_ < DUPN(15); ++rp_) for (int it = gw; it < DEPTH * T_L; it += NGW) {
            const int l = it / T_L; int r = it % T_L;
            if (r < T_IN) { int kb, nb; TR_DEC(r, 48, kb, nb); tr_tile(w_in_ + (size_t)l * DM * INW, INW, WSB(WS_WIN) + (size_t)l * INW * DM, DM, kb * 64, nb * 64, scr, lane); continue; } r -= T_IN;
            if (r < T_OUT) { int kb, nb; TR_DEC(r, 32, kb, nb);
                if (kb < 16) tr_tile(w_out_ + (size_t)l * DM * DM, DM, WSB(WS_WOUT) + (size_t)l * DM * DM, DM, kb * 64, nb * 64, scr, lane);
                else tr_tile(w_out_ + (size_t)l * DM * DM + (size_t)1024 * DM, DM, WSB(WS_WOT2) + (size_t)l * DM * 1024, 1024, (kb - 16) * 64, nb * 64, scr, lane);
                continue; } r -= T_OUT;
            if (r < T_1) { int kb, nb; TR_DEC(r, 128, kb, nb); tr_tile(w_mlp1_ + (size_t)l * DM * DFF, DFF, WSB(WS_W1) + (size_t)l * DFF * DM, DM, kb * 64, nb * 64, scr, lane); continue; } r -= T_1;
            { int kb, nb; TR_DEC(r, 32, kb, nb); tr_tile(w_mlp2_ + (size_t)l * DFF * DM, DM, WSB(WS_W2) + (size_t)l * DM * DFF, DFF, kb * 64, nb * 64, scr, lane); }
        }
    }
    const int gt = F.bx * (NWAVES * 64) + tid, NGT = F.G * NWAVES * 64;
    for (int i = gt; i < 2 * 262144; i += NGT) {
        const int which = i >> 18, o4 = i & 262143;
        const int d4 = o4 & 15, key = (o4 >> 4) & 511, kvh = (o4 >> 13) & 3, bl = o4 >> 15;
        const float* src = (which ? cache_v_ : cache_k_) + (((size_t)bl * 512 + key) * 4 + kvh) * 64 + d4 * 4;
        const f32x4 v = *(const f32x4*)src; v2u o; o.x = pk2(v[0], v[1]); o.y = pk2(v[2], v[3]);
        *(v2u*)((which ? WSB(WS_VC) : WSB(WS_KC)) + (size_t)o4 * 4) = o;
    }
    for (int i = gt; i < 1536; i += NGT) {
        const int fi = i & 15, p = (i < 512) ? (i >> 4) : ((i - 512) >> 4);
        const float inv = 1.0f / powf(10000.0f, (float)fi * (1.0f / 16.0f));
        const float ang = (float)p * inv;
        const float kq = rintf(ang * 0.15915494309189535f);
        float rr = fmaf(-kq, 6.2831854820251465f, ang); rr = fmaf(-kq, -1.7484555e-7f, rr);
        const float cs = cosf(rr), sn = sinf(rr);
        if (i < 512) { WSF(WS_ROPE)[i] = cs; WSF(WS_ROPE)[512 + i] = sn; } else { WSF(WS_ROPE)[1024 + (i - 512)] = cs; WSF(WS_ROPE)[2048 + (i - 512)] = sn; }
    }
    for (int i = gt; i < DEPTH * 1024 * 128; i += NGT) {
        const int j8 = (i & 127) * 8, k = (i >> 7) & 1023, l = i >> 17;
        float v[8];
#pragma unroll
        for (int e = 0; e < 8; ++e) v[e] = 0.f;
        if (k < 512) { const int g = k >> 7; if ((j8 >> 7) == g) { const float* wp = w_pool_ + (((size_t)l * 4 + g) * 128 + (k & 127)) * 128 + (j8 & 127); const float* ps = pool_scale_ + l * 512 + j8;
#pragma unroll
                for (int e = 0; e < 8; ++e) v[e] = wp[e] * ps[e]; } }
        else if (j8 >= 512) { const float* wp = w_conv_pw_ + ((size_t)l * 512 + (k - 512)) * 512 + (j8 - 512);
#pragma unroll
            for (int e = 0; e < 8; ++e) v[e] = wp[e]; }
        v4u o; o.x = pk2(v[0], v[1]); o.y = pk2(v[2], v[3]); o.z = pk2(v[4], v[5]); o.w = pk2(v[6], v[7]);
        *(v4u*)(WSB(WS_WBD) + ((size_t)l * 1024 + k) * 1024 + j8) = o;
    }
    if (tid == 0) { unsigned* cnt = (unsigned*)(A.ws + WS_CTL) + CW_GEMV; unsigned sp = 0u;
        while (xb_ld(cnt) < (unsigned)F.G) { __builtin_amdgcn_s_sleep(1); if (++sp > (1u << 22)) break; }
        __builtin_amdgcn_fence(__ATOMIC_ACQUIRE, "agent"); }
    __syncthreads();
    for (int i = gt; i < DEPTH * 3 * ADA; i += NGT) { const int j = i % ADA, lc = i / ADA, l = lc / 3, cv = lc % 3;
        float sacc = b_ada_[(size_t)l * ADA + j];
#pragma unroll
        for (int kp = 0; kp < 8; ++kp) sacc += WSF(WS_MODP)[((size_t)(kp * DEPTH + l) * 3 + cv) * ADA + j];
        WSF(WS_MODS)[i] = sacc; }
}

template <bool PART> __device__ __forceinline__ float mod_val(Frame& F, const Args& A, int l, int cv, int j) {
    if (!PART) return WSF(WS_MODS)[((size_t)l * 3 + cv) * ADA + j];
    float s = b_ada_[(size_t)l * ADA + j];
#pragma unroll
    for (int kp = 0; kp < 8; ++kp) s += WSF(WS_MODP)[((size_t)(kp * DEPTH + l) * 3 + cv) * ADA + j];
    return s;
}
template <int MODE, bool PART, int STAGE = 0>
__device__ __forceinline__ void thin_phase(Frame& F, const Args& A, const float* gpost, int gate_off, int l_gate, const float* gpre, int sc_off, int sh_off, int l_mod, bool x_from_inputs, const XcdBarrier* barp = nullptr) {
    PHASE_IDS();
    LAS float* PA = (LAS float*)F.lds; LAS float* PB = PA + 3 * DM; LAS float* PC = PB + 3 * DM;
    if (STAGE == 4) {
        asm volatile("s_waitcnt vmcnt(0)" ::: "memory");
        __syncthreads();
        if (wv == 0) { if (tid == 0) xcd_barrier_leader(*barp); }
        else {
#pragma unroll
            for (int k = 0; k < 14; ++k) { const int i = (tid - 64) + 448 * k; if (i < 3 * DM) { const int cv = i / DM, c = i % DM;
                if (MODE != 0) PA[i] = mod_val<PART>(F, A, l_gate, cv, gate_off + c) * gpost[c];
                if (MODE != 2) { PB[i] = gpre[c] * (1.f + mod_val<PART>(F, A, l_mod, cv, sc_off + c)); PC[i] = mod_val<PART>(F, A, l_mod, cv, sh_off + c); } } }
        }
    }
    if (STAGE != 2 && STAGE != 4) {
#pragma unroll
    for (int k = 0; k < 12; ++k) { const int i = tid + 512 * k, cv = i / DM, c = i % DM;
        if (MODE != 0) PA[i] = mod_val<PART>(F, A, l_gate, cv, gate_off + c) * gpost[c];
        if (MODE != 2) { PB[i] = gpre[c] * (1.f + mod_val<PART>(F, A, l_mod, cv, sc_off + c)); PC[i] = mod_val<PART>(F, A, l_mod, cv, sh_off + c); } }
    }
    if (STAGE == 1) return;
    __syncthreads();
    const int nchk = (MODE == 0) ? (F.bx < 128 ? 2 : 4) : 3;
    for (int ci = 0; ci < nchk; ++ci) { const int ch = (MODE == 0) ? (F.bx < 128 ? 2 * F.bx + ci : 256 + 4 * (F.bx - 128) + ci) : F.bx + 256 * ci;
#pragma unroll
        for (int rr = 0; rr < 2; ++rr) {
            const int row = ch * 16 + wv * 2 + rr;
            const int cv = row < MP ? 0 : (row < MP + SEQ_S ? 1 : 2);
            f32x4 xv[8];
            if (x_from_inputs) { const float* xin = row < MP ? x_prompt_ + (size_t)row * DM : x_sample_ + (size_t)(row - MP) * DM;
#pragma unroll
                for (int j = 0; j < 8; ++j) xv[j] = *(const f32x4*)(xin + 512 * (j >> 1) + 8 * lane + 4 * (j & 1)); }
            else { const bf16* xb = WSB(WS_XB) + (size_t)row * DM;
#pragma unroll
                for (int jj = 0; jj < 4; ++jj) { const v4u w = *(const v4u*)(xb + 512 * jj + 8 * lane);
                    xv[2 * jj] = (f32x4){bflo(w.x), bfhi(w.x), bflo(w.y), bfhi(w.y)}; xv[2 * jj + 1] = (f32x4){bflo(w.z), bfhi(w.z), bflo(w.w), bfhi(w.w)}; } }
            if (MODE != 0) {
                const bf16* mp = WSB(WS_MIX) + (size_t)row * DM; f32x4 mv[8]; float ss = 0.f;
#pragma unroll
                for (int jj = 0; jj < 4; ++jj) { const v4u w = *(const v4u*)(mp + 512 * jj + 8 * lane);
                    mv[2 * jj] = (f32x4){bflo(w.x), bfhi(w.x), bflo(w.y), bfhi(w.y)}; mv[2 * jj + 1] = (f32x4){bflo(w.z), bfhi(w.z), bflo(w.w), bfhi(w.w)}; }
                if (row >= MP) { const bf16* mp2 = WSB(WS_MIX2) + (size_t)(row - MP) * DM;
#pragma unroll
                    for (int jj = 0; jj < 4; ++jj) { const v4u w = *(const v4u*)(mp2 + 512 * jj + 8 * lane);
                        mv[2 * jj] = mv[2 * jj] + (f32x4){bflo(w.x), bfhi(w.x), bflo(w.y), bfhi(w.y)}; mv[2 * jj + 1] = mv[2 * jj + 1] + (f32x4){bflo(w.z), bfhi(w.z), bflo(w.w), bfhi(w.w)}; } }
#pragma unroll
                for (int j = 0; j < 8; ++j) ss += (mv[j][0] * mv[j][0] + mv[j][1] * mv[j][1]) + (mv[j][2] * mv[j][2] + mv[j][3] * mv[j][3]);
                const float r1 = __builtin_amdgcn_rsqf(wave_sum(ss) * (1.0f / DM) + EPS);
#pragma unroll
                for (int j = 0; j < 8; ++j) { const int co = 512 * (j >> 1) + 8 * lane + 4 * (j & 1); const f32x4 pa = *(const LAS f32x4*)(PA + cv * DM + co); xv[j] = xv[j] + pa * (mv[j] * r1); }
                if (MODE == 2) { float* xo = A.out + (size_t)row * DM;
#pragma unroll
                    for (int j = 0; j < 8; ++j) *(f32x4*)(xo + 512 * (j >> 1) + 8 * lane + 4 * (j & 1)) = xv[j]; }
                else { bf16* xo = WSB(WS_XB) + (size_t)row * DM;
#pragma unroll
                    for (int jj = 0; jj < 4; ++jj) { v4u o; o.x = pk2(xv[2 * jj][0], xv[2 * jj][1]); o.y = pk2(xv[2 * jj][2], xv[2 * jj][3]); o.z = pk2(xv[2 * jj + 1][0], xv[2 * jj + 1][1]); o.w = pk2(xv[2 * jj + 1][2], xv[2 * jj + 1][3]);
                        *(v4u*)(xo + 512 * jj + 8 * lane) = o; } }
            }
            if (MODE != 2) {
                float ss = 0.f;
#pragma unroll
                for (int j = 0; j < 8; ++j) ss += (xv[j][0] * xv[j][0] + xv[j][1] * xv[j][1]) + (xv[j][2] * xv[j][2] + xv[j][3] * xv[j][3]);
                const float r2 = __builtin_amdgcn_rsqf(wave_sum(ss) * (1.0f / DM) + EPS);
                bf16* hp = WSB(WS_H) + (size_t)row * DM;
#pragma unroll
                for (int jj = 0; jj < 4; ++jj) { const int co = 512 * jj + 8 * lane;
                    const f32x4 pb0 = *(const LAS f32x4*)(PB + cv * DM + co), pb1 = *(const LAS f32x4*)(PB + cv * DM + co + 4), pc0 = *(const LAS f32x4*)(PC + cv * DM + co), pc1 = *(const LAS f32x4*)(PC + cv * DM + co + 4);
                    const f32x4 h0 = (xv[2 * jj] * r2) * pb0 + pc0, h1 = (xv[2 * jj + 1] * r2) * pb1 + pc1;
                    v4u o; o.x = pk2(h0[0], h0[1]); o.y = pk2(h0[2], h0[3]); o.z = pk2(h1[0], h1[1]); o.w = pk2(h1[2], h1[3]); *(v4u*)(hp + co) = o; }
            }
        }
    }
    __syncthreads();
}

#define MFMA32(a, b, c) __builtin_amdgcn_mfma_f32_32x32x16_bf16((a), (b), (c), 0, 0, 0)
__device__ __forceinline__ int crow(int reg, int h) { return (reg & 3) + 8 * (reg >> 2) + 4 * h; }
constexpr int KS_LD = 72, VT_LD = 136;
template <bool LAT>
__device__ __forceinline__ void attn_unit(Frame& F, const Args& A, int layer, int unit) {
    LAS bf16* Ks = (LAS bf16*)F.lds; LAS bf16* Vt = (LAS bf16*)(F.lds + 128 * KS_LD * 2);
    asm volatile("" : "+s"(unit));
    PHASE_IDS(); const int w = wv, r = lane & 31, h = lane >> 5;
    int b, kvh, tq, qpos0 = 0, nb = 0;
    if (LAT) { kvh = unit & 3; nb = (unit >> 2) & 15; b = unit >> 6; qpos0 = nb * 128 + 32 * (w & 3); tq = MP + b * SEQ_S + qpos0; }
    else { const int half = unit & 1; kvh = (unit >> 1) & 3; b = unit >> 3; tq = b * SEQ_P + half * 128 + 32 * (w & 3); }
    const int hq0 = kvh * 4 + (w >> 2);
    bf16x8 q[2][4];
#pragma unroll
    for (int t = 0; t < 2; ++t) {
        v4u qraw[4];
        { const bf16* qp = WSB(WS_Z) + (size_t)(tq + r) * INW + (hq0 + 2 * t) * 64 + 8 * h;
#pragma unroll
          for (int s = 0; s < 4; ++s) qraw[s] = *(const v4u*)(qp + 16 * s); }
        if (LAT) {
            const int pos = qpos0 + r;
#pragma unroll
            for (int hf = 0; hf < 2; ++hf) {
                const float* ct = WSF(WS_ROPE) + (hf ? 1024 + (pos & 63) * 16 : (pos >> 6) * 16) + 8 * h; const float* st = ct + (hf ? 1024 : 512);
#pragma unroll
                for (int jj = 0; jj < 4; ++jj) { const float c0 = ct[2 * jj], c1 = ct[2 * jj + 1], s0 = st[2 * jj], s1 = st[2 * jj + 1];
                    const unsigned a = qraw[2 * hf][jj], bb = qraw[2 * hf + 1][jj];
                    const float u1l = bflo(a), u1h = bfhi(a), u2l = bflo(bb), u2h = bfhi(bb);
                    qraw[2 * hf][jj] = pk2(u1l * c0 - u2l * s0, u1h * c1 - u2h * s1); qraw[2 * hf + 1][jj] = pk2(u2l * c0 + u1l * s0, u2h * c1 + u1h * s1); }
            }
        }
#pragma unroll
        for (int s = 0; s < 4; ++s) q[t][s] = __builtin_bit_cast(bf16x8, qraw[s]);
    }
    f32x16 O[2][2];
#pragma unroll
    for (int t = 0; t < 2; ++t)
#pragma unroll
        for (int i = 0; i < 16; ++i) { O[t][0][i] = 0.f; O[t][1][i] = 0.f; }
    float mrun[2], lsum[2];
#pragma unroll
    for (int t = 0; t < 2; ++t) { mrun[t] = sink_[layer * 16 + hq0 + 2 * t] * LOG2E; lsum[t] = 1.0f; }
    constexpr float C2 = 0.125f * LOG2E;
    const int nch = LAT ? 7 : 2;
#define ATT_DESC(ci_, kb_, vb_, pitch_, rope_, kpos0_) do { \
        if (LAT) { if ((ci_) < 3) { const int j_ = nb - 1 + (ci_); const size_t row0_ = (size_t)MP + (size_t)b * SEQ_S + (size_t)j_ * 128; \
                kb_ = WSB(WS_Z) + row0_ * INW + OK_ + kvh * 64; vb_ = WSB(WS_Z) + row0_ * INW + OV_ + kvh * 64; pitch_ = INW; rope_ = true; kpos0_ = j_ * 128; } \
            else { const size_t off_ = ((size_t)((b * DEPTH + layer) * 4 + kvh) * 512 + (size_t)((ci_) - 3) * 128) * 64; kb_ = WSB(WS_KC) + off_; vb_ = WSB(WS_VC) + off_; pitch_ = 64; rope_ = false; kpos0_ = 0; } } \
        else { const size_t row0_ = (size_t)b * SEQ_P + (size_t)(ci_) * 128; kb_ = WSB(WS_Z) + row0_ * INW + OK_ + kvh * 64; vb_ = WSB(WS_Z) + row0_ * INW + OV_ + kvh * 64; pitch_ = INW; rope_ = false; kpos0_ = 0; } } while (0)
    const int skey = tid >> 2, spr = tid & 3, sc0 = (spr >> 1) * 32 + (spr & 1) * 8, vkey = (w & 1) * 64 + lane, vc = w >> 1;
    v4u pka, pkb, pv0, pv1;
    LAS float* RT = (LAS float*)(F.lds + 36864);
    if (LAT) { for (int i = tid; i < 768; i += 512) *(LAS f32x4*)(RT + 4 * i) = *(const f32x4*)(WSF(WS_ROPE) + 4 * i); }
#define ATT_LOAD(kb_, vb_, pitch_, rope_, kpos0_) do { \
        const bf16* src_ = (kb_) + (size_t)skey * (pitch_) + sc0; pka = *(const v4u*)src_; pkb = *(const v4u*)(src_ + 16); \
        pv0 = *(const v4u*)((vb_) + (size_t)vkey * (pitch_) + 8 * vc); pv1 = *(const v4u*)((vb_) + (size_t)vkey * (pitch_) + 8 * (vc + 4)); \
        } while (0)
    f32x16 XB;
#pragma unroll
    for (int i = 0; i < 16; ++i) XB[i] = 0.f;
    int ci = (LAT && nb == 0) ? 1 : 0;
    const bf16 *kb, *vb; int pitch; bool rope; int kpos0;
    ATT_DESC(ci, kb, vb, pitch, rope, kpos0);
    ATT_LOAD(kb, vb, pitch, rope, kpos0);
    for (;;) {
        __syncthreads();
        if (rope) {
            const int kpos_ = kpos0 + skey; const LAS float* ct_ = RT + ((spr >> 1) ? 1024 + (kpos_ & 63) * 16 : (kpos_ >> 6) * 16) + 8 * (spr & 1); const LAS float* st_ = ct_ + ((spr >> 1) ? 1024 : 512);
            const f32x4 pct0 = *(const LAS f32x4*)ct_, pct1 = *(const LAS f32x4*)(ct_ + 4), pst0 = *(const LAS f32x4*)st_, pst1 = *(const LAS f32x4*)(st_ + 4);
            const float cc[8] = {pct0[0], pct0[1], pct0[2], pct0[3], pct1[0], pct1[1], pct1[2], pct1[3]}, sn[8] = {pst0[0], pst0[1], pst0[2], pst0[3], pst1[0], pst1[1], pst1[2], pst1[3]};
            v4u o1, o2;
#pragma unroll
            for (int jj = 0; jj < 4; ++jj) { const float c0f = cc[2 * jj], c1f = cc[2 * jj + 1], s0f = sn[2 * jj], s1f = sn[2 * jj + 1];
                const float u1l = bflo(pka[jj]), u1h = bfhi(pka[jj]), u2l = bflo(pkb[jj]), u2h = bfhi(pkb[jj]);
                o1[jj] = pk2(u1l * c0f - u2l * s0f, u1h * c1f - u2h * s1f); o2[jj] = pk2(u2l * c0f + u1l * s0f, u2h * c1f + u1h * s1f); }
            *(LAS v4u*)(Ks + skey * KS_LD + sc0) = o1; *(LAS v4u*)(Ks + skey * KS_LD + sc0 + 16) = o2;
        } else { *(LAS v4u*)(Ks + skey * KS_LD + sc0) = pka; *(LAS v4u*)(Ks + skey * KS_LD + sc0 + 16) = pkb; }
#pragma unroll
        for (int e = 0; e < 4; ++e) { Vt[(8 * vc + 2 * e) * VT_LD + vkey] = (bf16)(pv0[e] & 0xffffu); Vt[(8 * vc + 2 * e + 1) * VT_LD + vkey] = (bf16)(pv0[e] >> 16);
            Vt[(8 * (vc + 4) + 2 * e) * VT_LD + vkey] = (bf16)(pv1[e] & 0xffffu); Vt[(8 * (vc + 4) + 2 * e + 1) * VT_LD + vkey] = (bf16)(pv1[e] >> 16); }
        __syncthreads();
        const bool mask = rope; const int mpos0 = kpos0;
        int nci = ci + 1; if (LAT && nci == 2 && nb == 15) nci = 3;
        const bool has_next = nci < nch;
        if (has_next) { ATT_DESC(nci, kb, vb, pitch, rope, kpos0); ATT_LOAD(kb, vb, pitch, rope, kpos0); }
        const int wj = w & 3;
        const int kt_lo = (LAT && mask && ci == 0) ? wj : 0, kt_hi = (LAT && mask && ci == 2) ? wj + 1 : 4;
#pragma unroll 1
        for (int kt = kt_lo; kt < kt_hi; ++kt) {
            const bool dmask = LAT && mask && ci != 1 && kt == wj;
            if (LAT) { if (dmask) {
#pragma unroll
                for (int i = 0; i < 16; ++i) { const int rel = (mpos0 + 32 * kt + crow(i, h)) - (qpos0 + r); XB[i] = (rel > 128 || rel < -128) ? -1.0e30f : 0.f; } } }
            bf16x8 kf[4];
#pragma unroll
            for (int s = 0; s < 4; ++s) kf[s] = *(const LAS bf16x8*)(Ks + (32 * kt + r) * KS_LD + 16 * s + 8 * h);
            bf16x8 vf[2][2];
#pragma unroll
            for (int s = 0; s < 2; ++s) {
                const LAS bf16* v0p = Vt + r * VT_LD + 32 * kt + 16 * s + 4 * h; const LAS bf16* v1p = v0p + 32 * VT_LD;
                const s16x4 a0 = *(const LAS s16x4*)v0p, a1 = *(const LAS s16x4*)(v0p + 8), b0 = *(const LAS s16x4*)v1p, b1 = *(const LAS s16x4*)(v1p + 8);
                vf[0][s] = __builtin_shufflevector(a0, a1, 0, 1, 2, 3, 4, 5, 6, 7); vf[1][s] = __builtin_shufflevector(b0, b1, 0, 1, 2, 3, 4, 5, 6, 7);
            }
#pragma unroll
            for (int t = 0; t < 2; ++t) {
                f32x16 X;
                if (LAT) X = XB;
                else {
#pragma unroll
                    for (int i = 0; i < 16; ++i) X[i] = 0.f; }
#pragma unroll
                for (int s = 0; s < 4; ++s) X = MFMA32(kf[s], q[t][s], X);
                float p[16]; float mx = -3.0e38f;
#pragma unroll
                for (int i = 0; i < 16; ++i) { float v = X[i];
                    p[i] = v; mx = fmaxf(mx, v); }
                mx = fmaxf(mx, __shfl_xor(mx, 32));
                const float mrun_old = mrun[t]; const float mnew = fmaxf(mrun_old, mx * C2), alpha = __builtin_amdgcn_exp2f(mrun_old - mnew);
                float rs = 0.f;
#pragma unroll
                for (int i = 0; i < 16; ++i) { p[i] = __builtin_amdgcn_exp2f(fmaf(p[i], C2, -mnew)); rs += p[i]; }
                rs += __shfl_xor(rs, 32);
                lsum[t] = lsum[t] * alpha + rs; mrun[t] = mnew;
                if (__builtin_amdgcn_ballot_w64(mnew != mrun_old) != 0ull) {
#pragma unroll
                    for (int i = 0; i < 16; ++i) { O[t][0][i] *= alpha; O[t][1][i] *= alpha; } }
                v4u p0, p1;
#pragma unroll
                for (int jj = 0; jj < 4; ++jj) { p0[jj] = pk2(p[2 * jj], p[2 * jj + 1]); p1[jj] = pk2(p[8 + 2 * jj], p[9 + 2 * jj]); }
                const bf16x8 pf0 = __builtin_bit_cast(bf16x8, p0), pf1 = __builtin_bit_cast(bf16x8, p1);
                O[t][0] = MFMA32(vf[0][0], pf0, O[t][0]); O[t][1] = MFMA32(vf[1][0], pf0, O[t][1]);
                O[t][0] = MFMA32(vf[0][1], pf1, O[t][0]); O[t][1] = MFMA32(vf[1][1], pf1, O[t][1]);
            }
            if (LAT) { if (dmask) {
#pragma unroll
                for (int i = 0; i < 16; ++i) XB[i] = 0.f; } }
        }
        if (!has_next) break;
        ci = nci;
    }
#undef ATT_DESC
#undef ATT_LOAD
#pragma unroll
    for (int t = 0; t < 2; ++t) {
        const float inv = 1.0f / lsum[t];
        bf16* op = WSB(WS_MIXCAT) + (size_t)(tq + r) * DM + (hq0 + 2 * t) * 64 + 4 * h;
#pragma unroll
        for (int gi = 0; gi < 4; ++gi) {
            v2u o; o.x = pk2(O[t][0][4 * gi] * inv, O[t][0][4 * gi + 1] * inv); o.y = pk2(O[t][0][4 * gi + 2] * inv, O[t][0][4 * gi + 3] * inv); *(v2u*)(op + 8 * gi) = o;
            v2u o2; o2.x = pk2(O[t][1][4 * gi] * inv, O[t][1][4 * gi + 1] * inv); o2.y = pk2(O[t][1][4 * gi + 2] * inv, O[t][1][4 * gi + 3] * inv); *(v2u*)(op + 32 + 8 * gi) = o2;
        }
    }
}

__device__ __forceinline__ void attn_ctx_pair(Frame& F, const Args& A, int layer, int pair, v4u (&pre)[6], int next_ti) {
    asm volatile("" : "+s"(pair));
    PHASE_IDS(); const int w = wv, r = lane & 31, h = lane >> 5;
    const int kvh = pair & 3, b = pair >> 2;
    const int hq0 = kvh * 4 + (w >> 2);
    constexpr int IMG = 36864;
    const int skey = tid >> 2, spr = tid & 3, sc0 = (spr >> 1) * 32 + (spr & 1) * 8, vkey = (w & 1) * 64 + lane, vc = w >> 1;
    const float sk0 = sink_[layer * 16 + hq0], sk1 = sink_[layer * 16 + hq0 + 2];
    v4u qn[2][4];
#define CTX_QLOAD(half_) do { const int tq_ = b * SEQ_P + (half_) * 128 + 32 * (w & 3); _Pragma("unroll") for (int t = 0; t < 2; ++t) { const bf16* qp = WSB(WS_Z) + (size_t)(tq_ + r) * INW + (hq0 + 2 * t) * 64 + 8 * h; \
        _Pragma("unroll") for (int s = 0; s < 4; ++s) qn[t][s] = *(const v4u*)(qp + 16 * s); } } while (0)
    {
        v4u ka[2], kb2[2], va[2], vb2[2];
#pragma unroll
        for (int c = 0; c < 2; ++c) { const size_t row0 = (size_t)b * SEQ_P + (size_t)c * 128;
            const bf16* ksrc = WSB(WS_Z) + (row0 + skey) * INW + OK_ + kvh * 64 + sc0; ka[c] = *(const v4u*)ksrc; kb2[c] = *(const v4u*)(ksrc + 16);
            const bf16* vsrc = WSB(WS_Z) + (row0 + vkey) * INW + OV_ + kvh * 64; va[c] = *(const v4u*)(vsrc + 8 * vc); vb2[c] = *(const v4u*)(vsrc + 8 * (vc + 4)); }
        CTX_QLOAD(0);
        __syncthreads();
#pragma unroll
        for (int c = 0; c < 2; ++c) { LAS bf16* Ks = (LAS bf16*)(F.lds + c * IMG); LAS bf16* Vt = Ks + 128 * KS_LD;
            *(LAS v4u*)(Ks + skey * KS_LD + sc0) = ka[c]; *(LAS v4u*)(Ks + skey * KS_LD + sc0 + 16) = kb2[c];
#pragma unroll
            for (int e = 0; e < 4; ++e) { Vt[(8 * vc + 2 * e) * VT_LD + vkey] = (bf16)(va[c][e] & 0xffffu); Vt[(8 * vc + 2 * e + 1) * VT_LD + vkey] = (bf16)(va[c][e] >> 16);
                Vt[(8 * (vc + 4) + 2 * e) * VT_LD + vkey] = (bf16)(vb2[c][e] & 0xffffu); Vt[(8 * (vc + 4) + 2 * e + 1) * VT_LD + vkey] = (bf16)(vb2[c][e] >> 16); } }
    }
    __syncthreads();
    constexpr float C2 = 0.125f * LOG2E;
#pragma unroll 1
    for (int half = 0; half < 2; ++half) {
        const int tq = b * SEQ_P + half * 128 + 32 * (w & 3);
        bf16x8 q[2][4];
#pragma unroll
        for (int t = 0; t < 2; ++t)
#pragma unroll
            for (int s = 0; s < 4; ++s) q[t][s] = __builtin_bit_cast(bf16x8, qn[t][s]);
        if (half == 0) CTX_QLOAD(1);
        else if (next_ti >= 0) {
            const int nt0 = next_ti * 32; int nseq0, nS;
            if (nt0 < MP) { nseq0 = nt0 & ~(SEQ_P - 1); nS = SEQ_P; } else { nseq0 = MP + ((nt0 - MP) & ~(SEQ_S - 1)); nS = SEQ_S; }
            const int ns0 = nt0 - nseq0;
#pragma unroll
            for (int k = 0; k < 6; ++k) { const int i = tid + 512 * k, row = i >> 6, ch8 = (i & 63) * 8, s = ns0 - 8 + row, sc = s < 0 ? 0 : (s >= nS ? nS - 1 : s);
                pre[k] = *(const v4u*)(WSB(WS_Z) + (size_t)(nseq0 + sc) * INW + OPU + ch8); }
        }
        f32x16 O[2][2];
#pragma unroll
        for (int t = 0; t < 2; ++t)
#pragma unroll
            for (int i = 0; i < 16; ++i) { O[t][0][i] = 0.f; O[t][1][i] = 0.f; }
        float mrun[2], lsum[2];
#pragma unroll
        for (int t = 0; t < 2; ++t) { mrun[t] = (t ? sk1 : sk0) * LOG2E; lsum[t] = 1.0f; }
#pragma unroll 1
        for (int kt8 = 0; kt8 < 8; ++kt8) {
            const int c = kt8 >> 2, kt = kt8 & 3;
            const LAS bf16* Ks = (const LAS bf16*)(F.lds + c * IMG); const LAS bf16* Vt = Ks + 128 * KS_LD;
            bf16x8 kf[4];
#pragma unroll
            for (int s = 0; s < 4; ++s) kf[s] = *(const LAS bf16x8*)(Ks + (32 * kt + r) * KS_LD + 16 * s + 8 * h);
            bf16x8 vf[2][2];
#pragma unroll
            for (int s = 0; s < 2; ++s) {
                const LAS bf16* v0p = Vt + r * VT_LD + 32 * kt + 16 * s + 4 * h; const LAS bf16* v1p = v0p + 32 * VT_LD;
                const s16x4 a0 = *(const LAS s16x4*)v0p, a1 = *(const LAS s16x4*)(v0p + 8), b0 = *(const LAS s16x4*)v1p, b1 = *(const LAS s16x4*)(v1p + 8);
                vf[0][s] = __builtin_shufflevector(a0, a1, 0, 1, 2, 3, 4, 5, 6, 7); vf[1][s] = __builtin_shufflevector(b0, b1, 0, 1, 2, 3, 4, 5, 6, 7);
            }
#pragma unroll
            for (int t = 0; t < 2; ++t) {
                f32x16 X;
#pragma unroll
                for (int i = 0; i < 16; ++i) X[i] = 0.f;
#pragma unroll
                for (int s = 0; s < 4; ++s) X = MFMA32(kf[s], q[t][s], X);
                float p[16]; float mx = -3.0e38f;
#pragma unroll
                for (int i = 0; i < 16; ++i) { p[i] = X[i]; mx = fmaxf(mx, X[i]); }
                mx = fmaxf(mx, __shfl_xor(mx, 32));
                const float mrun_old = mrun[t]; const float mnew = fmaxf(mrun_old, mx * C2), alpha = __builtin_amdgcn_exp2f(mrun_old - mnew);
                float rs = 0.f;
#pragma unroll
                for (int i = 0; i < 16; ++i) { p[i] = __builtin_amdgcn_exp2f(fmaf(p[i], C2, -mnew)); rs += p[i]; }
                rs += __shfl_xor(rs, 32);
                lsum[t] = lsum[t] * alpha + rs; mrun[t] = mnew;
                if (__builtin_amdgcn_ballot_w64(mnew != mrun_old) != 0ull) {
#pragma unroll
                    for (int i = 0; i < 16; ++i) { O[t][0][i] *= alpha; O[t][1][i] *= alpha; } }
                v4u p0, p1;
#pragma unroll
                for (int jj = 0; jj < 4; ++jj) { p0[jj] = pk2(p[2 * jj], p[2 * jj + 1]); p1[jj] = pk2(p[8 + 2 * jj], p[9 + 2 * jj]); }
                const bf16x8 pf0 = __builtin_bit_cast(bf16x8, p0), pf1 = __builtin_bit_cast(bf16x8, p1);
                O[t][0] = MFMA32(vf[0][0], pf0, O[t][0]); O[t][1] = MFMA32(vf[1][0], pf0, O[t][1]);
                O[t][0] = MFMA32(vf[0][1], pf1, O[t][0]); O[t][1] = MFMA32(vf[1][1], pf1, O[t][1]);
            }
        }
#pragma unroll
        for (int t = 0; t < 2; ++t) {
            const float inv = 1.0f / lsum[t];
            bf16* op = WSB(WS_MIXCAT) + (size_t)(tq + r) * DM + (hq0 + 2 * t) * 64 + 4 * h;
#pragma unroll
            for (int gi = 0; gi < 4; ++gi) {
                v2u o; o.x = pk2(O[t][0][4 * gi] * inv, O[t][0][4 * gi + 1] * inv); o.y = pk2(O[t][0][4 * gi + 2] * inv, O[t][0][4 * gi + 3] * inv); *(v2u*)(op + 8 * gi) = o;
                v2u o2; o2.x = pk2(O[t][1][4 * gi] * inv, O[t][1][4 * gi + 1] * inv); o2.y = pk2(O[t][1][4 * gi + 2] * inv, O[t][1][4 * gi + 3] * inv); *(v2u*)(op + 32 + 8 * gi) = o2;
            }
        }
    }
#undef CTX_QLOAD
}

template <int HW> __device__ __forceinline__ void pool_g(const Args& A, const LAS bf16* RAW, int S, int s0, int t0, int c) {
    constexpr int W = 2 * HW; float u[32 + W];
#pragma unroll
    for (int jj = 0; jj < 32 + W; ++jj) u[jj] = bf2f(RAW[(8 - HW + jj) * 512 + c]);
    float sum = 0.f;
#pragma unroll
    for (int jj = 0; jj < W; ++jj) sum += u[jj];
    const bool interior = (s0 >= HW) && (s0 + 31 + HW <= S);
    bf16* op = WSB(WS_MIXCAT) + (size_t)t0 * DM + 1024 + c;
#pragma unroll
    for (int o = 0; o < 32; ++o) {
        float rc = 1.0f / (float)W;
        if (!interior) { const int so = s0 + o; const int lo = so - HW > 0 ? so - HW : 0, hi = so + HW < S ? so + HW : S; rc = __builtin_amdgcn_rcpf((float)(hi - lo)); }
        const float pooled = fmaf(sum, rc, -u[o + HW]);
        const unsigned pk = pk2(pooled, 0.f); op[(size_t)o * DM] = (bf16)(pk & 0xffffu);
        if (o < 31) sum += u[o + W] - u[o]; }
}
__device__ __forceinline__ void convpool_tile(Frame& F, const Args& A, int layer, int ti, v4u (&pre)[6], bool have_pre, int next_ti) {
    asm volatile("" : "+s"(ti));
    const int t0 = ti * 32; int seq0, S;
    if (t0 < MP) { seq0 = t0 & ~(SEQ_P - 1); S = SEQ_P; } else { seq0 = MP + ((t0 - MP) & ~(SEQ_S - 1)); S = SEQ_S; }
    PHASE_IDS(); const int s0 = t0 - seq0, c = tid;
    LAS bf16* RAW = (LAS bf16*)F.lds;
    __syncthreads();
    {
        v4u st[6];
        if (have_pre) {
#pragma unroll
            for (int k = 0; k < 6; ++k) st[k] = pre[k];
        } else {
#pragma unroll
            for (int k = 0; k < 6; ++k) { const int i = tid + 512 * k, row = i >> 6, ch8 = (i & 63) * 8, s = s0 - 8 + row, sc = s < 0 ? 0 : (s >= S ? S - 1 : s);
                st[k] = *(const v4u*)(WSB(WS_Z) + (size_t)(seq0 + sc) * INW + OPU + ch8); }
        }
#pragma unroll
        for (int k = 0; k < 6; ++k) { const int i = tid + 512 * k, row = i >> 6, s = s0 - 8 + row; if (s < 0 || s >= S) st[k] = (v4u){0u, 0u, 0u, 0u}; }
#pragma unroll
        for (int k = 0; k < 6; ++k) { const int i = tid + 512 * k, row = i >> 6, ch8 = (i & 63) * 8; *(LAS v4u*)(RAW + row * 512 + ch8) = st[k]; }
    }
    const bool prompt = t0 < MP;
    v4u pf[16];
    if (prompt) {
#pragma unroll
        for (int k = 0; k < 16; ++k) { const int i = tid + 512 * k, row = (i >> 7) < 62 ? (i >> 7) : 61, ch8 = (i & 127) * 8, s = s0 - 15 + row, sc = s < 0 ? 0 : (s >= S ? S - 1 : s);
            pf[k] = *(const v4u*)(WSB(WS_Z) + (size_t)(seq0 + sc) * INW + OCA + ch8); }
    } else {
#pragma unroll
        for (int k = 0; k < 4; ++k) { const int i = tid + 512 * k, row = i >> 7, ch8 = (i & 127) * 8, s = s0 - 15 + row, sc = s < 0 ? 0 : (s >= S ? S - 1 : s);
            const bf16* pp = WSB(WS_ZP) + (size_t)(seq0 - MP + sc) * 1024 + ch8;
#pragma unroll
            for (int qk = 0; qk < 4; ++qk) pf[4 * k + qk] = *(const v4u*)(pp + (size_t)qk * MS * 1024); }
    }
    __syncthreads();
    switch (c >> 7) { case 0: pool_g<1>(A, RAW, S, s0, t0, c); break; case 1: pool_g<2>(A, RAW, S, s0, t0, c); break; case 2: pool_g<4>(A, RAW, S, s0, t0, c); break; default: pool_g<8>(A, RAW, S, s0, t0, c); break; }
    __syncthreads();
    if (prompt) {
#pragma unroll
        for (int k = 0; k < 16; ++k) { const int i = tid + 512 * k, row = i >> 7, ch8 = (i & 127) * 8, s = s0 - 15 + row; v4u v = pf[k]; if (s < 0 || s >= S) v = (v4u){0u, 0u, 0u, 0u}; if (row < 62) *(LAS v4u*)(RAW + row * 1024 + ch8) = v; }
    } else {
#pragma unroll 1
        for (int kb = 0; kb < 4; ++kb) {
            if (kb > 0) {
#pragma unroll
                for (int k = 0; k < 4; ++k) { const int i = tid + 512 * (4 * kb + k), row = (i >> 7) < 62 ? (i >> 7) : 61, ch8 = (i & 127) * 8, s = s0 - 15 + row, sc = s < 0 ? 0 : (s >= S ? S - 1 : s);
                    const bf16* pp = WSB(WS_ZP) + (size_t)(seq0 - MP + sc) * 1024 + ch8;
#pragma unroll
                    for (int qk = 0; qk < 4; ++qk) pf[4 * k + qk] = *(const v4u*)(pp + (size_t)qk * MS * 1024); }
            }
#pragma unroll
            for (int k = 0; k < 4; ++k) { const int i = tid + 512 * (4 * kb + k), row = i >> 7, ch8 = (i & 127) * 8, s = s0 - 15 + row;
                float acc8[8];
#pragma unroll
                for (int e = 0; e < 8; ++e) acc8[e] = 0.f;
#pragma unroll
                for (int qk = 0; qk < 4; ++qk)
#pragma unroll
                    for (int e = 0; e < 4; ++e) { acc8[2 * e] += bflo(pf[4 * k + qk][e]); acc8[2 * e + 1] += bfhi(pf[4 * k + qk][e]); }
                v4u v; v.x = pk2(acc8[0], acc8[1]); v.y = pk2(acc8[2], acc8[3]); v.z = pk2(acc8[4], acc8[5]); v.w = pk2(acc8[6], acc8[7]);
                if (s < 0 || s >= S) v = (v4u){0u, 0u, 0u, 0u};
                if (row < 62) *(LAS v4u*)(RAW + row * 1024 + ch8) = v; }
        }
    }
    float wt[31], hv[62];
#pragma unroll
    for (int j = 0; j < 31; ++j) wt[j] = conv_dw_[((size_t)layer * 31 + j) * 512 + c];
    const float cb = conv_b_[layer * 512 + c];
    __syncthreads();
#pragma unroll
    for (int jj = 0; jj < 62; ++jj) { const float a = bf2f(RAW[jj * 1024 + c]), g = bf2f(RAW[jj * 1024 + 512 + c]); hv[jj] = a * __builtin_amdgcn_rcpf(1.f + __expf(-g)); }
    float acc[32];
#pragma unroll
    for (int o = 0; o < 32; ++o) { float a = cb;
#pragma unroll
        for (int j = 0; j < 31; ++j) a = fmaf(hv[o + j], wt[j], a);
        acc[o] = a; }
    LAS float* CT = (LAS float*)F.lds;
    __syncthreads();
#pragma unroll
    for (int o = 0; o < 32; ++o) CT[o * 512 + c] = acc[o];
    __syncthreads();
    if (next_ti >= 0) {
        const int nt0 = next_ti * 32; int nseq0, nS;
        if (nt0 < MP) { nseq0 = nt0 & ~(SEQ_P - 1); nS = SEQ_P; } else { nseq0 = MP + ((nt0 - MP) & ~(SEQ_S - 1)); nS = SEQ_S; }
        const int ns0 = nt0 - nseq0;
#pragma unroll
        for (int k = 0; k < 6; ++k) { const int i = tid + 512 * k, row = i >> 6, ch8 = (i & 63) * 8, s = ns0 - 8 + row, sc = s < 0 ? 0 : (s >= nS ? nS - 1 : s);
            pre[k] = *(const v4u*)(WSB(WS_Z) + (size_t)(nseq0 + sc) * INW + OPU + ch8); }
    }
    f32x4 lg0 = *(const f32x4*)(conv_ln_g_ + layer * 512 + 8 * lane), lg1 = *(const f32x4*)(conv_ln_g_ + layer * 512 + 8 * lane + 4);
    f32x4 lb0 = *(const f32x4*)(conv_ln_b_ + layer * 512 + 8 * lane), lb1 = *(const f32x4*)(conv_ln_b_ + layer * 512 + 8 * lane + 4);
#pragma unroll 1
    for (int qq = 0; qq < 4; ++qq) {
        const int o = 4 * wv + qq;
        f32x4 v0 = *(const LAS f32x4*)(CT + o * 512 + 8 * lane), v1 = *(const LAS f32x4*)(CT + o * 512 + 8 * lane + 4);
        const float mu = wave_sum((v0[0] + v0[1]) + (v0[2] + v0[3]) + (v1[0] + v1[1]) + (v1[2] + v1[3])) * (1.0f / 512.0f);
        v0 = v0 - mu; v1 = v1 - mu;
        const float var = wave_sum((v0[0] * v0[0] + v0[1] * v0[1]) + (v0[2] * v0[2] + v0[3] * v0[3]) + (v1[0] * v1[0] + v1[1] * v1[1]) + (v1[2] * v1[2] + v1[3] * v1[3])) * (1.0f / 512.0f);
        const float rstd = __builtin_amdgcn_rsqf(var + EPS);
        f32x4 y0 = v0 * rstd * lg0 + lb0, y1 = v1 * rstd * lg1 + lb1;
#pragma unroll
        for (int e = 0; e < 4; ++e) { y0[e] = y0[e] * __builtin_amdgcn_rcpf(1.f + __expf(-y0[e])); y1[e] = y1[e] * __builtin_amdgcn_rcpf(1.f + __expf(-y1[e])); }
        v4u ov; ov.x = pk2(y0[0], y0[1]); ov.y = pk2(y0[2], y0[3]); ov.z = pk2(y1[0], y1[1]); ov.w = pk2(y1[2], y1[3]);
        *(v4u*)(WSB(WS_MIXCAT) + (size_t)(t0 + o) * DM + 1536 + 8 * lane) = ov;
    }
}

__global__ void __launch_bounds__(NWAVES * 64, 2) fwd_kernel(Args args) {
    extern __shared__ __attribute__((aligned(16))) unsigned char lds[];
    Frame F;
    F.lds = (LAS unsigned char*)lds;
    F.G = gridDim.x; F.bx = blockIdx.x;
    const Args& A = args;
    unsigned char* ws = args.ws;
    volatile LAS unsigned* MISC = (volatile LAS unsigned*)(F.lds + MISC_OFF);
    if (threadIdx.x < 32) MISC[threadIdx.x] = 0u;
    __syncthreads();
    XcdBarrier bar = xcd_barrier_post((unsigned*)(ws + WS_CTL) + CW_BAR, MISC + 8);

    for (int rep = 0; rep < DUPN(0); ++rep) { if (PH(0)) p0a(F, A);
    xcd_barrier(bar); }
    for (int rp_ = 0; rp_ < DUPN(1); ++rp_) {
        const int fl = F.bx >> 5, fu = F.bx & 31;
        pg8::OneUnit S; S.has = F.bx < 128; S.pm = fu >> 2; S.pn = fu & 3;
        S.kt0 = (S.pn == 0) ? 0 : (S.pn == 1 ? 4 : 8); S.nt = (S.pn < 2) ? 4 : 8;
        const int fls = S.has ? fl : 0;
        pg8::Gemm g{WSB(WS_WOT2) + (size_t)fls * DM * 1024, WSB(WS_WBD) + (size_t)fls * 1024 * 1024, DM, 1024, 1024};
        pg8::EpiB<0, false> E{WSB(WS_WOUT) + (size_t)fls * DM * DM + 1024, DM, nullptr, nullptr, 0, nullptr, 0, 0, 0};
        if (PH(1)) pg8::gemm_phase<pg8::EpiB<0, false>, pg8::OneUnit, false, true>(F.lds, g, S, E);
        __syncthreads();
        const int gt = F.bx * (NWAVES * 64) + (int)threadIdx.x, NGT = F.G * NWAVES * 64;
        if (PH(2)) thin_phase<0, false>(F, A, nullptr, 0, 0, g_pre1_, DM, 0, 0, true);
    }
    xcd_barrier(bar);

    for (int l = 0; l < DEPTH; ++l) {
        for (int rep = 0; rep < DUPN(3); ++rep) {
            pg8::Gemm g{WSB(WS_H), WSB(WS_WIN) + (size_t)l * INW * DM, M, INW, DM}; pg8::P1Order S; S.c = F.bx; S.nt = DM / 64;
            pg8::EpiB<0, true> E{WSB(WS_Z), INW, A.out + OUT_NK, A.out + OUT_NV, l, WSB(WS_ZP), 1024, (size_t)MS * 1024, 2048};
            if (PH(3)) pg8::gemm_phase<pg8::EpiB<0, true>, pg8::P1Order, true, true>(F.lds, g, S, E);
        xcd_barrier(bar);
        }
        for (int rep = 0; rep < DUPN(4); ++rep) {
            v4u pre[6];
#pragma unroll
            for (int k = 0; k < 6; ++k) pre[k] = (v4u){0u, 0u, 0u, 0u};
            if (F.bx < 128) { if (PH(4)) { attn_unit<true>(F, A, l, F.bx); __syncthreads(); } }
            else if (PH(5)) { attn_ctx_pair(F, A, l, F.bx - 128, pre, F.bx); __syncthreads(); }
            if (PH(6)) { const int ntile = F.bx < 128 ? 1 : 2;
#pragma unroll 1
                for (int k = 0; k < ntile; ++k) { convpool_tile(F, A, l, F.bx + 128 * k, pre, k > 0 || F.bx >= 128, (k + 1 < ntile) ? F.bx + 128 * (k + 1) : -1); __syncthreads(); } }
        xcd_barrier(bar);
        }
        for (int rep = 0; rep < DUPN(7); ++rep) {
            pg8::Gemm g{WSB(WS_MIXCAT), WSB(WS_WOUT) + (size_t)l * DM * DM, M, DM, DM}; pg8::SplitOrder S; S.c = F.bx; S.nt = DM / 64;
            pg8::EpiB<0, false> E{WSB(WS_MIX), DM, nullptr, nullptr, 0, WSB(WS_MIX2), DM, 0, 0};
            if (PH(7)) pg8::gemm_phase<pg8::EpiB<0, false>, pg8::SplitOrder, true, true>(F.lds, g, S, E);
            if (rep + 1 < DUPN(7)) xcd_barrier(bar);
        }
        thin_phase<1, false, 4>(F, A, g_post1_ + l * DM, 2 * DM, l, g_pre2_ + l * DM, 4 * DM, 3 * DM, l, l == 0, &bar);
        xcd_barrier(bar);
        for (int rep = 0; rep < DUPN(9); ++rep) {
            pg8::Gemm g{WSB(WS_H), WSB(WS_W1) + (size_t)l * DFF * DM, M, DFF, DM}; pg8::StaticOrder S; S.init(M, DFF, DM, F.G, F.bx);
            pg8::EpiB<1, false> E{WSB(WS_U), DFF, nullptr, nullptr, 0, nullptr, 0, 0, 0};
            if (PH(9)) pg8::gemm_phase<pg8::EpiB<1, false>, pg8::StaticOrder, true, true>(F.lds, g, S, E);
        xcd_barrier(bar);
        }
        for (int rep = 0; rep < DUPN(10); ++rep) {
            pg8::Gemm g{WSB(WS_U), WSB(WS_W2) + (size_t)l * DM * DFF, M, DM, DFF}; pg8::SplitOrder S; S.c = F.bx; S.nt = DFF / 64;
            pg8::EpiB<0, false> E{WSB(WS_MIX), DM, nullptr, nullptr, 0, WSB(WS_MIX2), DM, 0, 0};
            if (PH(10)) pg8::gemm_phase<pg8::EpiB<0, false>, pg8::SplitOrder, true, true>(F.lds, g, S, E);
            if (rep + 1 < DUPN(10)) xcd_barrier(bar);
        }
        if (l + 1 < DEPTH) { thin_phase<1, false, 4>(F, A, g_post2_ + l * DM, 5 * DM, l, g_pre1_ + (l + 1) * DM, DM, 0, l + 1, false, &bar); xcd_barrier(bar); }
        else thin_phase<2, false, 4>(F, A, g_post2_ + l * DM, 5 * DM, l, nullptr, 0, 0, l, false, &bar);
    }
}

extern "C" void kernel_launch(void* const* d_in, const int* in_sizes, int n_in, void* d_out, int out_size, void* d_ws, size_t ws_size, hipStream_t stream) {
    static int grid = 0;
    if (grid == 0) {
        if (n_in != 24 || ws_size < WS_END) { fprintf(stderr, "kernel_launch: bad arguments (n_in %d, ws %zu)\n", n_in, ws_size); grid = -1; return; }
        int dev = 0, cus = 0, per_cu = 0;
        if (hipGetDevice(&dev) != hipSuccess || hipDeviceGetAttribute(&cus, hipDeviceAttributeMultiprocessorCount, dev) != hipSuccess) { grid = -1; return; }
        if (hipFuncSetAttribute((const void*)fwd_kernel, hipFuncAttributeMaxDynamicSharedMemorySize, LDS_BYTES) != hipSuccess) { fprintf(stderr, "kernel_launch: hipFuncSetAttribute failed\n"); grid = -1; return; }
        if (hipOccupancyMaxActiveBlocksPerMultiprocessor(&per_cu, (const void*)fwd_kernel, NWAVES * 64, LDS_BYTES) != hipSuccess || per_cu < 1) { fprintf(stderr, "kernel_launch: occupancy query says %d\n", per_cu); per_cu = 1; }
        (void)hipGetLastError();
        if (cus < 256) { fprintf(stderr, "kernel_launch: needs 256 CUs, found %d\n", cus); grid = -1; return; }
        grid = 256;
    }
    if (grid < 0) return;
    (void)in_sizes; (void)out_size;
    if (hipMemsetAsync((char*)d_ws + WS_CTL, 0, CTL_ZERO_BYTES, stream) != hipSuccess) return;
    Args a{};
    for (int i = 0; i < 24; ++i) a.in[i] = (const float*)d_in[i];
    a.out = (float*)d_out; a.ws = (unsigned char*)d_ws;
    hipLaunchKernelGGL(fwd_kernel, dim3(grid), dim3(NWAVES * 64), LDS_BYTES, stream, a);
}
```
